# Optimizing an MI355X kernel written in HIP

```python
import jax, jax.numpy as jnp
from jax import lax
import numpy as np

D_MODEL = 1024
BATCH = 4
SEQ = 4096
DEPTH = 2

GRID_W = 64
CTX_LEN = 256
POOL_WIDTH = 512
POOL_GROUPS = 4
POOL_GROUP_DIM = POOL_WIDTH // POOL_GROUPS
POOL_WINDOWS = (2, 4, 8, 16)
N_HEADS = 8
N_KV_HEADS = 2
HEAD_DIM = 64
Q_GROUP = N_HEADS // N_KV_HEADS
ATTN_WIDTH = N_HEADS * HEAD_DIM
KV_WIDTH = N_KV_HEADS * HEAD_DIM
MIX_WIDTH = POOL_WIDTH + ATTN_WIDTH
PROJ_WIDTH = POOL_WIDTH + ATTN_WIDTH + 2 * KV_WIDTH
WINDOW = 128
BLOCK = 128
ROPE_BASE = 10000.0
ROPE_AXIS_DIM = HEAD_DIM // 2
D_FF = 2816
N_MOD = 9
EPS = 1e-6
NEG_INF = -1e30

kernel_name = "hybrid_pool_swa_macaron_dit_block"


def rmsnorm(x, g):
    xf = x.astype(jnp.float32)
    y = xf * lax.rsqrt(jnp.mean(xf * xf, axis=-1, keepdims=True) + EPS)
    return (y * g.astype(jnp.float32)).astype(x.dtype)


def norm_modulate(x, g, shift, scale):
    return rmsnorm(x, g) * (1 + scale) + shift


def swiglu(n, w_in, w_out):
    a, b = jnp.split(n @ w_in, 2, axis=-1)
    return (jax.nn.silu(a) * b) @ w_out


def axial_rope_tables(T):
    rows = T // GRID_W
    row = jnp.repeat(jnp.arange(rows), GRID_W).astype(jnp.float32)
    col = jnp.tile(jnp.arange(GRID_W), rows).astype(jnp.float32)
    inv = ROPE_BASE ** (-jnp.arange(0, ROPE_AXIS_DIM, 2, dtype=jnp.float32) / ROPE_AXIS_DIM)
    ang = jnp.concatenate([row[:, None] * inv, col[:, None] * inv], axis=-1)
    return jnp.cos(ang), jnp.sin(ang)


def apply_rope(x, cos, sin):
    xf = x.astype(jnp.float32)
    x1, x2 = xf[..., :HEAD_DIM // 2], xf[..., HEAD_DIM // 2:]
    c, s = cos[None, :, None, :], sin[None, :, None, :]
    return jnp.concatenate([x1 * c - x2 * s, x2 * c + x1 * s], axis=-1).astype(x.dtype)


def pool_mixer(u, w_pool, pool_scale):
    B, T, _ = u.shape
    uf = u.astype(jnp.float32)
    cs = jnp.pad(jnp.cumsum(uf, axis=1), ((0, 0), (1, 0), (0, 0)))
    t = jnp.arange(T)
    outs = []
    for g, w in enumerate(POOL_WINDOWS):
        lo = jnp.clip(t - w // 2, 0, T)
        hi = jnp.clip(t + w - w // 2, 0, T)
        csg = cs[..., g * POOL_GROUP_DIM:(g + 1) * POOL_GROUP_DIM]
        outs.append((csg[:, hi] - csg[:, lo]) / (hi - lo).astype(jnp.float32)[None, :, None])
    pooled = (jnp.concatenate(outs, axis=-1) - uf).astype(u.dtype)
    pooled = pooled.reshape(B, T, POOL_GROUPS, POOL_GROUP_DIM)
    mixed = jnp.einsum("btgc,gcd->btgd", pooled, w_pool).reshape(B, T, POOL_WIDTH)
    return mixed * pool_scale


def latent_attention(q, k, v, kc, vc, sink):
    B, T = q.shape[:2]
    nb = T // BLOCK
    scale = HEAD_DIM ** -0.5
    qb = q.reshape(B, nb, BLOCK, N_KV_HEADS, Q_GROUP, HEAD_DIM)
    pad = ((0, 0), (BLOCK, BLOCK), (0, 0), (0, 0))
    kp = jnp.pad(k, pad).reshape(B, nb + 2, BLOCK, N_KV_HEADS, HEAD_DIM)
    vp = jnp.pad(v, pad).reshape(B, nb + 2, BLOCK, N_KV_HEADS, HEAD_DIM)
    kb = jnp.concatenate([kp[:, :-2], kp[:, 1:-1], kp[:, 2:]], axis=2)
    vb = jnp.concatenate([vp[:, :-2], vp[:, 1:-1], vp[:, 2:]], axis=2)
    s_loc = jnp.einsum("bnqhgd,bnkhd->bnhgqk", qb, kb).astype(jnp.float32) * scale
    n_idx = jnp.arange(nb)[:, None, None]
    qpos = n_idx * BLOCK + jnp.arange(BLOCK)[None, :, None]
    kpos = n_idx * BLOCK + jnp.arange(3 * BLOCK)[None, None, :] - BLOCK
    valid = (kpos >= 0) & (kpos < T) & (jnp.abs(kpos - qpos) <= WINDOW)
    s_loc = jnp.where(valid[None, :, None, None], s_loc, NEG_INF)
    s_ctx = jnp.einsum("bnqhgd,bmhd->bnhgqm", qb, kc).astype(jnp.float32) * scale
    s_sink = jnp.broadcast_to(sink.astype(jnp.float32).reshape(1, 1, N_KV_HEADS, Q_GROUP, 1, 1),
                              s_loc.shape[:-1] + (1,))
    p = jax.nn.softmax(jnp.concatenate([s_loc, s_ctx, s_sink], axis=-1), axis=-1)
    L = kc.shape[1]
    p_loc = p[..., :3 * BLOCK].astype(v.dtype)
    p_ctx = p[..., 3 * BLOCK:3 * BLOCK + L].astype(v.dtype)
    o = jnp.einsum("bnhgqk,bnkhd->bnqhgd", p_loc, vb) + jnp.einsum("bnhgqm,bmhd->bnqhgd", p_ctx, vc)
    return o.reshape(B, T, ATTN_WIDTH)


def context_attention(qc, kc, vc, sink):
    B, L = qc.shape[:2]
    qg = qc.reshape(B, L, N_KV_HEADS, Q_GROUP, HEAD_DIM)
    s = jnp.einsum("blhgd,bmhd->bhglm", qg, kc).astype(jnp.float32) * HEAD_DIM ** -0.5
    s_sink = jnp.broadcast_to(sink.astype(jnp.float32).reshape(1, N_KV_HEADS, Q_GROUP, 1, 1),
                              s.shape[:-1] + (1,))
    p = jax.nn.softmax(jnp.concatenate([s, s_sink], axis=-1), axis=-1)[..., :L].astype(vc.dtype)
    return jnp.einsum("bhglm,bmhd->blhgd", p, vc).reshape(B, L, ATTN_WIDTH)


def context_kv(nc, w_in):
    B, L = nc.shape[:2]
    kc, vc = jnp.split(nc @ w_in[:, MIX_WIDTH:], 2, axis=-1)
    return (kc.reshape(B, L, N_KV_HEADS, HEAD_DIM), vc.reshape(B, L, N_KV_HEADS, HEAD_DIM))


def mix_latent(n, kc, vc, w_in, w_pool, pool_scale, sink, w_out, cos, sin):
    B, T = n.shape[:2]
    u, q, k, v = jnp.split(n @ w_in, [POOL_WIDTH, MIX_WIDTH, MIX_WIDTH + KV_WIDTH], axis=-1)
    pool_out = pool_mixer(u, w_pool, pool_scale)
    q = apply_rope(q.reshape(B, T, N_HEADS, HEAD_DIM), cos, sin)
    k = apply_rope(k.reshape(B, T, N_KV_HEADS, HEAD_DIM), cos, sin)
    v = v.reshape(B, T, N_KV_HEADS, HEAD_DIM)
    attn_out = latent_attention(q, k, v, kc, vc, sink)
    return jnp.concatenate([pool_out, attn_out], axis=-1) @ w_out


def mix_context(nc, kc, vc, w_in, w_pool, pool_scale, sink, w_out):
    B, L = nc.shape[:2]
    u, q = jnp.split(nc @ w_in[:, :MIX_WIDTH], [POOL_WIDTH], axis=-1)
    pool_out = pool_mixer(u, w_pool, pool_scale)
    attn_out = context_attention(q.reshape(B, L, N_HEADS, HEAD_DIM), kc, vc, sink)
    return jnp.concatenate([pool_out, attn_out], axis=-1) @ w_out


def setup_inputs(seed: int = 0) -> dict:
    key = jax.random.key(seed)
    ks = jax.random.split(key, 24)
    f32 = jnp.float32
    nrm = lambda k, shape, s: jax.random.normal(k, shape, f32) * s
    gain = lambda k, shape: 1.0 + 0.1 * jax.random.normal(k, shape, f32)
    return {
        "x": nrm(ks[0], (BATCH, SEQ, D_MODEL), 1.0),
        "c": nrm(ks[1], (BATCH, D_MODEL), 1.0),
        "ctx": nrm(ks[2], (BATCH, CTX_LEN, D_MODEL), 1.0),
        "c_ctx": nrm(ks[3], (D_MODEL,), 1.0),
        "w_mod": nrm(ks[4], (DEPTH, D_MODEL, N_MOD * D_MODEL), D_MODEL ** -0.5),
        "b_mod": nrm(ks[5], (DEPTH, N_MOD * D_MODEL), 0.02),
        "norm_ffn1": gain(ks[6], (DEPTH, D_MODEL)),
        "w_ffn1_in": nrm(ks[7], (DEPTH, D_MODEL, 2 * D_FF), D_MODEL ** -0.5),
        "w_ffn1_out": nrm(ks[8], (DEPTH, D_FF, D_MODEL), D_FF ** -0.5),
        "norm_mix": gain(ks[9], (DEPTH, D_MODEL)),
        "w_in": nrm(ks[10], (DEPTH, D_MODEL, PROJ_WIDTH), D_MODEL ** -0.5),
        "w_pool": nrm(ks[11], (DEPTH, POOL_GROUPS, POOL_GROUP_DIM, POOL_GROUP_DIM), POOL_GROUP_DIM ** -0.5),
        "pool_scale": gain(ks[12], (DEPTH, POOL_WIDTH)),
        "sink": nrm(ks[13], (DEPTH, N_HEADS), 1.0),
        "w_out": nrm(ks[14], (DEPTH, MIX_WIDTH, D_MODEL), MIX_WIDTH ** -0.5),
        "norm_ffn2": gain(ks[15], (DEPTH, D_MODEL)),
        "w_ffn2_in": nrm(ks[16], (DEPTH, D_MODEL, 2 * D_FF), D_MODEL ** -0.5),
        "w_ffn2_out": nrm(ks[17], (DEPTH, D_FF, D_MODEL), D_FF ** -0.5),
        "norm_final": gain(ks[18], (D_MODEL,)),
    }


def reference(x, c, ctx, c_ctx, w_mod, b_mod, norm_ffn1, w_ffn1_in, w_ffn1_out, norm_mix, w_in,
              w_pool, pool_scale, sink, w_out, norm_ffn2, w_ffn2_in, w_ffn2_out, norm_final):
    B = x.shape[0]
    cos, sin = axial_rope_tables(x.shape[1])
    h, hc = x, ctx
    for l in range(DEPTH):
        last = l == DEPTH - 1
        mx = (jax.nn.silu(c) @ w_mod[l] + b_mod[l]).reshape(B, N_MOD, 1, D_MODEL)
        mc = (jax.nn.silu(c_ctx) @ w_mod[l] + b_mod[l]).reshape(N_MOD, D_MODEL)
        h = h + 0.5 * mx[:, 2] * swiglu(norm_modulate(h, norm_ffn1[l], mx[:, 0], mx[:, 1]),
                                         w_ffn1_in[l], w_ffn1_out[l])
        hc = hc + 0.5 * mc[2] * swiglu(norm_modulate(hc, norm_ffn1[l], mc[0], mc[1]),
                                        w_ffn1_in[l], w_ffn1_out[l])
        n = norm_modulate(h, norm_mix[l], mx[:, 3], mx[:, 4])
        nc = norm_modulate(hc, norm_mix[l], mc[3], mc[4])
        kc, vc = context_kv(nc, w_in[l])
        h = h + mx[:, 5] * mix_latent(n, kc, vc, w_in[l], w_pool[l], pool_scale[l], sink[l], w_out[l], cos, sin)
        if not last:
            hc = hc + mc[5] * mix_context(nc, kc, vc, w_in[l], w_pool[l], pool_scale[l], sink[l], w_out[l])
            hc = hc + 0.5 * mc[8] * swiglu(norm_modulate(hc, norm_ffn2[l], mc[6], mc[7]),
                                            w_ffn2_in[l], w_ffn2_out[l])
        h = h + 0.5 * mx[:, 8] * swiglu(norm_modulate(h, norm_ffn2[l], mx[:, 6], mx[:, 7]),
                                         w_ffn2_in[l], w_ffn2_out[l])
    return rmsnorm(h, norm_final)
```

```cpp
#include <hip/hip_runtime.h>
#include <hip/hip_cooperative_groups.h>
#include <cstdio>
#include <cstdint>
namespace cg = cooperative_groups;
namespace pg8 {
#define PG8_LAS __attribute__((address_space(3)))
typedef unsigned short bf16_t;
typedef short bf16x8 __attribute__((ext_vector_type(8)));
typedef float f32x4 __attribute__((ext_vector_type(4)));
typedef unsigned u32x4 __attribute__((ext_vector_type(4)));
constexpr int BM = 256, BK = 64, HALF = 128, HTB = HALF * BK * 2  , STAGE_BYTES = 8 * HTB, NXCD = 8, WGM = 8;

__host__ __device__ __forceinline__ int lds_byte(int r, int c) { const int st = (r >> 4) * 2 + (c >> 5), rr = r & 15, cc = c & 31, ob = rr * 64 + cc * 2; return st * 1024 + (ob ^ (((ob >> 9) & 1) << 5)); }
__host__ __device__ __forceinline__ void stage_rc(int b, int& R, int& C) { const int st = b / 1024, sb = b % 1024, swz = sb ^ (((sb >> 9) & 1) << 5); R = (st >> 1) * 16 + swz / 64; C = (st & 1) * 32 + (swz % 64) / 2; }
__host__ __device__ __forceinline__ int perm32(int rho) { const int n = rho >> 4, i = rho & 15; return 8 * (i >> 2) + 4 * n + (i & 3); }

struct Unit { int pm, pn, k0, nk, fl; };
struct Gemm { const bf16_t* A; const bf16_t* Bt; int M, N, K; };
typedef float f32x2_t __attribute__((ext_vector_type(2))); typedef __bf16 bf16x2_t __attribute__((ext_vector_type(2)));
__device__ __forceinline__ unsigned cvt_pk_bf16(float lo, float hi) { f32x2_t v = {lo, hi}; bf16x2_t b = __builtin_convertvector(v, bf16x2_t); return __builtin_bit_cast(unsigned, b); }
typedef float f32x2 __attribute__((ext_vector_type(2)));

template <int NN> __device__ __forceinline__ void tile_of(int L, int nM, int& pm, int& pn) {
    static_assert(NXCD == 8 && WGM == 8, "shifts below");
    const int nwg = nM * NN; int wgid = L;
    { const int q = nwg >> 3, r = nwg & 7, xcd = wgid & 7, off = wgid >> 3; wgid = (xcd < r ? xcd * (q + 1) : r * (q + 1) + (xcd - r) * q) + off; }
    constexpr int nig = WGM * NN; const int gid = wgid / nig, rem = wgid - gid * nig, fm = gid * WGM, gsz = (nM - fm) < WGM ? (nM - fm) : WGM;
    if (gsz == WGM) { pm = fm + (rem & 7); pn = rem >> 3; } else { pm = fm + rem % gsz; pn = rem / gsz; }
}
template <int NN> struct Sched {
    int nM, nkt, G, c, nmain, nctxu, nsplit, kper;
    __device__ __forceinline__ bool next(int i, Unit& u) const {
        const int L = i * G + c;
        if (L < nmain) { tile_of<NN>(L, nM, u.pm, u.pn); u.k0 = 0; u.nk = nkt; u.fl = 0; return true; }
        const int s = L - nmain; if (s >= nctxu * nsplit) return false;
        const int uu = s / nsplit, ks = s - uu * nsplit; u.pm = nM + uu / NN; u.pn = uu % NN; u.k0 = ks * kper; u.nk = kper; u.fl = 1; return true;
    }
    __device__ __forceinline__ void a_ready(const Unit&) const {}
    __device__ __forceinline__ void done(const Unit&) const {}
};
__device__ __forceinline__ float silu_mul(float a, float b) { const float e = __builtin_amdgcn_exp2f(a * -1.4426950408889634f); return a * b * __builtin_amdgcn_rcpf(1.0f + e); }
struct EpiSwiglu {
    static constexpr bool PERM = true, AFTER_DRAIN = false;
    bf16_t* O; int ldc;
    __device__ __forceinline__ void operator()(const f32x4 (&acc)[2][2][4][2], const Unit& u, int wr, int wc, int fr, int fq) const {
        const int row0 = u.pm * BM + wr * 64 + fr, col0 = u.pn * HALF + wc * 32 + 8 * fq;
#pragma unroll
        for (int ai = 0; ai < 2; ++ai)
#pragma unroll
            for (int m = 0; m < 4; ++m) { bf16_t* rowp = O + (size_t)(row0 + ai * HALF + m * 16) * ldc + col0;
                const f32x4 a0 = acc[ai][0][m][0], a1 = acc[ai][0][m][1], b0 = acc[ai][1][m][0], b1 = acc[ai][1][m][1];
                u32x4 w; w.x = cvt_pk_bf16(silu_mul(a0[0], b0[0]), silu_mul(a0[1], b0[1])); w.y = cvt_pk_bf16(silu_mul(a0[2], b0[2]), silu_mul(a0[3], b0[3]));
                w.z = cvt_pk_bf16(silu_mul(a1[0], b1[0]), silu_mul(a1[1], b1[1])); w.w = cvt_pk_bf16(silu_mul(a1[2], b1[2]), silu_mul(a1[3], b1[3]));
                *(u32x4*)rowp = w; }
    }
};
struct EpiRes {
    static constexpr bool PERM = true, AFTER_DRAIN = false;
    const float* basef; bf16_t* Hb; const float* gate; int gstride; float coef; bf16_t* slab;
    __device__ __forceinline__ void operator()(const f32x4 (&acc)[2][2][4][2], const Unit& u, int wr, int wc, int fr, int fq) const {
        const int bidx = u.pm < 64 ? (u.pm >> 4) : 4; const float* gp = gate + (size_t)bidx * gstride;
        const int col0 = u.pn * BM + wc * 32 + 8 * fq;
        f32x4 gv[2][2];
#pragma unroll
        for (int bj = 0; bj < 2; ++bj)
#pragma unroll
            for (int n = 0; n < 2; ++n) gv[bj][n] = *(const f32x4*)(gp + col0 + bj * HALF + n * 4) * coef;
        const bool f32base = (basef != nullptr) && (u.pm < 64);
#pragma unroll
        for (int ai = 0; ai < 2; ++ai)
#pragma unroll
            for (int m = 0; m < 4; ++m) { const size_t off = (size_t)(u.pm * BM + ai * HALF + wr * 64 + m * 16 + fr) * 1024 + col0;
#pragma unroll
                for (int bj = 0; bj < 2; ++bj) { const size_t o = off + bj * HALF; const f32x4 v0 = acc[ai][bj][m][0] * gv[bj][0], v1 = acc[ai][bj][m][1] * gv[bj][1];
                    if (u.fl) { u32x4 w; w.x = cvt_pk_bf16(v0[0], v0[1]); w.y = cvt_pk_bf16(v0[2], v0[3]); w.z = cvt_pk_bf16(v1[0], v1[1]); w.w = cvt_pk_bf16(v1[2], v1[3]);
                        *(u32x4*)(slab + (size_t)(u.k0 >> 2) * (1024 * 1024) + (o - (size_t)16384 * 1024)) = w; }
                    else { f32x4 b0, b1;
                        if (f32base) { b0 = *(const f32x4*)(basef + o); b1 = *(const f32x4*)(basef + o + 4); }
                        else { const u32x4 w = *(const u32x4*)(Hb + o); b0 = (f32x4){__builtin_bit_cast(float, w.x << 16), __builtin_bit_cast(float, w.x & 0xffff0000u), __builtin_bit_cast(float, w.y << 16), __builtin_bit_cast(float, w.y & 0xffff0000u)};
                            b1 = (f32x4){__builtin_bit_cast(float, w.z << 16), __builtin_bit_cast(float, w.z & 0xffff0000u), __builtin_bit_cast(float, w.w << 16), __builtin_bit_cast(float, w.w & 0xffff0000u)}; }
                        b0 += v0; b1 += v1; u32x4 w; w.x = cvt_pk_bf16(b0[0], b0[1]); w.y = cvt_pk_bf16(b0[2], b0[3]); w.z = cvt_pk_bf16(b1[0], b1[1]); w.w = cvt_pk_bf16(b1[2], b1[3]);
                        *(u32x4*)(Hb + o) = w; } } }
    }
};
struct EpiQKV {
    static constexpr bool PERM = true, AFTER_DRAIN = false;
    bf16_t* O; const float* ropeC; const float* ropeS; float qscale;
    __device__ __forceinline__ void operator()(const f32x4 (&acc)[2][2][4][2], const Unit& u, int wr, int wc, int fr, int fq) const {
        const int row0 = u.pm * BM + wr * 64 + fr; const bool latent = u.pm < 64;
        if (u.pn < 2 || (u.pn == 4 && wc >= 2)) {
#pragma unroll
            for (int bj = 0; bj < 2; ++bj) { const int col = (u.pn < 2) ? (u.pn * BM + bj * HALF + wc * 32 + 8 * fq) : (1152 + bj * 64 + (wc - 2) * 32 + 8 * fq);
#pragma unroll
                for (int ai = 0; ai < 2; ++ai)
#pragma unroll
                    for (int m = 0; m < 4; ++m) { const f32x4 v0 = acc[ai][bj][m][0], v1 = acc[ai][bj][m][1];
                        u32x4 w; w.x = cvt_pk_bf16(v0[0], v0[1]); w.y = cvt_pk_bf16(v0[2], v0[3]); w.z = cvt_pk_bf16(v1[0], v1[1]); w.w = cvt_pk_bf16(v1[2], v1[3]);
                        *(u32x4*)(O + (size_t)(row0 + ai * HALF + m * 16) * 1280 + col) = w; } }
        } else {
            const int dst1 = u.pn * BM + wc * 64 + 8 * fq; const float sc = (u.pn < 4) ? qscale : 1.0f; const int fb = 8 * (fq & 1);
#pragma unroll
            for (int ai = 0; ai < 2; ++ai)
#pragma unroll
                for (int m = 0; m < 4; ++m) { const int r = row0 + ai * HALF + m * 16; const int t = r & 4095; const int pos = (fq < 2) ? (t >> 6) : (t & 63);
                    f32x4 c0 = (f32x4){1.f, 1.f, 1.f, 1.f}, c1 = c0, s0 = (f32x4){0.f, 0.f, 0.f, 0.f}, s1 = s0;
                    if (latent) { c0 = *(const f32x4*)(ropeC + pos * 16 + fb); c1 = *(const f32x4*)(ropeC + pos * 16 + fb + 4); s0 = *(const f32x4*)(ropeS + pos * 16 + fb); s1 = *(const f32x4*)(ropeS + pos * 16 + fb + 4); }
                    const f32x4 xa0 = acc[ai][0][m][0], xa1 = acc[ai][0][m][1], xb0 = acc[ai][1][m][0], xb1 = acc[ai][1][m][1];
                    const f32x4 y10 = (xa0 * c0 - xb0 * s0) * sc, y11 = (xa1 * c1 - xb1 * s1) * sc, y20 = (xb0 * c0 + xa0 * s0) * sc, y21 = (xb1 * c1 + xa1 * s1) * sc;
                    u32x4 w1, w2; w1.x = cvt_pk_bf16(y10[0], y10[1]); w1.y = cvt_pk_bf16(y10[2], y10[3]); w1.z = cvt_pk_bf16(y11[0], y11[1]); w1.w = cvt_pk_bf16(y11[2], y11[3]);
                    w2.x = cvt_pk_bf16(y20[0], y20[1]); w2.y = cvt_pk_bf16(y20[2], y20[3]); w2.z = cvt_pk_bf16(y21[0], y21[1]); w2.w = cvt_pk_bf16(y21[2], y21[3]);
                    bf16_t* rp = O + (size_t)r * 1280 + dst1; *(u32x4*)rp = w1; *(u32x4*)(rp + 32) = w2; }
        }
    }
};

template <class Epi, class Sched, bool ALIGN_EPI = false, bool SP2 = false>
__device__ __forceinline__ void gemm_phase(PG8_LAS unsigned char* lds, const Gemm g, const Sched& S, const Epi& E) {
    int tid_ = threadIdx.x; asm volatile("" : "+v"(tid_));
    const int tid = tid_, wid = __builtin_amdgcn_readfirstlane(tid >> 6), lane = tid & 63, wr = wid >> 2, wc = wid & 3, fr = lane & 15, fq = lane >> 4;
    const int K = g.K;
    unsigned voffA[2], voffB[2];
#pragma unroll
    for (int i = 0; i < 2; ++i) { int R, C; stage_rc(tid * 16 + i * 8192, R, C); const int Rb = Epi::PERM ? ((R & ~31) + perm32(R & 31)) : R;
        voffA[i] = (unsigned)(R * K + C) * 2u; voffB[i] = (unsigned)(Rb * K + C) * 2u; }
    const size_t kstep = (size_t)(BK * 2);
    const size_t hstep = (size_t)HALF * K * 2;
    const size_t tstep = 2 * hstep;
    const unsigned ldsw = (unsigned)wid * 1024u;
    const int aoff = lds_byte(wr * 64 + fr, fq * 8), boff = lds_byte(wc * 32 + fr, fq * 8);
#define PG8_SA(b, h) (((b) * 2 + (h)) * HTB)
#define PG8_SB(b, h) ((4 + (b) * 2 + (h)) * HTB)
#define PG8_STAGE(bufoff, gbase, voff) do { _Pragma("unroll") for (int _i = 0; _i < 2; ++_i) \
        __builtin_amdgcn_global_load_lds((const unsigned*)((const char*)(gbase) + (voff)[_i]), (PG8_LAS unsigned*)(lds + (bufoff) + ldsw + _i * 8192), 16, 0, 0); } while (0)
#define PG8_LDA(dst, b, h) do { _Pragma("unroll") for (int m = 0; m < 4; ++m) _Pragma("unroll") for (int k = 0; k < 2; ++k) dst[m][k] = *(const PG8_LAS bf16x8*)(lds + PG8_SA(b, h) + aoff + m * 2048 + k * 1024); } while (0)
#define PG8_LDB(dst, b, h) do { _Pragma("unroll") for (int n = 0; n < 2; ++n) _Pragma("unroll") for (int k = 0; k < 2; ++k) dst[n][k] = *(const PG8_LAS bf16x8*)(lds + PG8_SB(b, h) + boff + n * 2048 + k * 1024); } while (0)
#define PG8_MMA(ai, bj, At, Bt) do { __builtin_amdgcn_s_setprio(1); _Pragma("unroll") for (int m = 0; m < 4; ++m) _Pragma("unroll") for (int n = 0; n < 2; ++n) _Pragma("unroll") for (int k = 0; k < 2; ++k) \
        acc[ai][bj][m][n] = __builtin_amdgcn_mfma_f32_16x16x32_bf16(Bt[n][k], At[m][k], acc[ai][bj][m][n], 0, 0, 0); __builtin_amdgcn_s_setprio(0); } while (0)
#define PG8_WAIT_V(n) asm volatile("s_waitcnt vmcnt(" #n ")" ::: "memory")
#define PG8_WAIT_L(n) asm volatile("s_waitcnt lgkmcnt(" #n ")" ::: "memory")
#define PG8_BAR __builtin_amdgcn_s_barrier()
#define PG8_SCHED __builtin_amdgcn_sched_barrier(0)
    Unit cur, nxt; int ui = 0;
    if (!S.next(0, cur)) return;
    f32x4 acc[2][2][4][2];
#pragma unroll
    for (int a = 0; a < 2; ++a)
#pragma unroll
        for (int b = 0; b < 2; ++b)
#pragma unroll
            for (int m = 0; m < 4; ++m)
#pragma unroll
                for (int n = 0; n < 2; ++n) acc[a][b][m][n] = (f32x4){0.f, 0.f, 0.f, 0.f};
    bf16x8 At[4][2], B0[2][2], B1[2][2];
    const char* cA = (const char*)g.A + (size_t)cur.pm * tstep + (size_t)cur.k0 * kstep; const char* cB = (const char*)g.Bt + (size_t)cur.pn * tstep + (size_t)cur.k0 * kstep;
    S.a_ready(cur);
    if constexpr (SP2) {
        PG8_STAGE(PG8_SB(0, 0), cB, voffB); PG8_STAGE(PG8_SB(0, 1), cB + hstep, voffB); PG8_STAGE(PG8_SA(0, 0), cA, voffA); PG8_STAGE(PG8_SA(0, 1), cA + hstep, voffA);
        if (wr == 1) PG8_BAR;
        PG8_WAIT_V(2); PG8_BAR;
        PG8_STAGE(PG8_SB(1, 0), cB + kstep, voffB); PG8_STAGE(PG8_SA(1, 0), cA + kstep, voffA); PG8_STAGE(PG8_SB(1, 1), cB + hstep + kstep, voffB);
        PG8_WAIT_V(6); PG8_BAR;
    } else {
        PG8_STAGE(PG8_SB(0, 0), cB, voffB); PG8_STAGE(PG8_SA(0, 0), cA, voffA); PG8_STAGE(PG8_SB(0, 1), cB + hstep, voffB); PG8_STAGE(PG8_SA(0, 1), cA + hstep, voffA);
        if (wr == 1) PG8_BAR;
        PG8_WAIT_V(4); PG8_BAR;
        PG8_STAGE(PG8_SB(1, 0), cB + kstep, voffB); PG8_STAGE(PG8_SA(1, 0), cA + kstep, voffA); PG8_STAGE(PG8_SB(1, 1), cB + hstep + kstep, voffB);
        PG8_WAIT_V(6); PG8_BAR;
    }
    for (;;) {
        const bool has_next = S.next(ui + 1, nxt);
        const char* nA = has_next ? (const char*)g.A + (size_t)nxt.pm * tstep + (size_t)nxt.k0 * kstep : cA; const char* nB = has_next ? (const char*)g.Bt + (size_t)nxt.pn * tstep + (size_t)nxt.k0 * kstep : cB;
        const int nt = cur.nk;
        for (int t = 0; t < nt; t += 2) {
            const bool last = (t == nt - 2);
            const char* a1 = cA + (size_t)(t + 1) * kstep;
            const char* a2 = last ? nA : cA + (size_t)(t + 2) * kstep; const char* b2 = last ? nB : cB + (size_t)(t + 2) * kstep;
            const char* a3 = a2 + kstep; const char* b3 = b2 + kstep;
            if (last && has_next) S.a_ready(nxt);
            if constexpr (SP2) {
            PG8_LDB(B0, 0, 0); PG8_LDB(B1, 0, 1); PG8_SCHED; PG8_LDA(At, 0, 0); PG8_STAGE(PG8_SA(1, 1), a1 + hstep, voffA);
            PG8_WAIT_V(8); PG8_WAIT_L(0); PG8_BAR; PG8_MMA(0, 0, At, B0); PG8_MMA(0, 1, At, B1); PG8_BAR; PG8_SCHED;
            PG8_LDA(At, 0, 1); PG8_STAGE(PG8_SB(0, 0), b2, voffB); PG8_STAGE(PG8_SB(0, 1), b2 + hstep, voffB); PG8_STAGE(PG8_SA(0, 0), a2, voffA);
            PG8_WAIT_V(8); PG8_WAIT_L(0); PG8_BAR; PG8_MMA(1, 0, At, B0); PG8_MMA(1, 1, At, B1); PG8_BAR; PG8_SCHED;
            PG8_LDB(B0, 1, 0); PG8_LDB(B1, 1, 1); PG8_SCHED; PG8_LDA(At, 1, 0); PG8_STAGE(PG8_SA(0, 1), a2 + hstep, voffA);
            PG8_WAIT_V(8); PG8_WAIT_L(0); PG8_BAR; PG8_MMA(0, 0, At, B0); PG8_MMA(0, 1, At, B1); PG8_BAR; PG8_SCHED;
            PG8_LDA(At, 1, 1); PG8_STAGE(PG8_SB(1, 0), b3, voffB); PG8_STAGE(PG8_SB(1, 1), b3 + hstep, voffB); PG8_STAGE(PG8_SA(1, 0), a3, voffA);
            PG8_WAIT_V(8); PG8_WAIT_L(0); PG8_BAR; PG8_MMA(1, 0, At, B0); PG8_MMA(1, 1, At, B1); PG8_BAR; PG8_SCHED;
            } else {
            PG8_LDB(B0, 0, 0); PG8_SCHED; PG8_LDA(At, 0, 0); PG8_STAGE(PG8_SA(1, 1), a1 + hstep, voffA);
            PG8_WAIT_L(8); PG8_BAR; PG8_WAIT_L(0); PG8_MMA(0, 0, At, B0); PG8_BAR; PG8_SCHED;
            PG8_LDB(B1, 0, 1); PG8_STAGE(PG8_SB(0, 0), b2, voffB);
            PG8_BAR; PG8_WAIT_L(0); PG8_MMA(0, 1, At, B1); PG8_BAR;
            PG8_LDA(At, 0, 1); PG8_STAGE(PG8_SA(0, 0), a2, voffA);
            PG8_BAR; PG8_WAIT_L(0); PG8_MMA(1, 0, At, B0); PG8_BAR; PG8_SCHED;
            PG8_STAGE(PG8_SB(0, 1), b2 + hstep, voffB);
            PG8_WAIT_V(6); PG8_BAR; PG8_MMA(1, 1, At, B1); PG8_BAR;
            PG8_LDB(B0, 1, 0); PG8_SCHED; PG8_LDA(At, 1, 0); PG8_STAGE(PG8_SA(0, 1), a2 + hstep, voffA);
            PG8_WAIT_L(8); PG8_BAR; PG8_WAIT_L(0); PG8_MMA(0, 0, At, B0); PG8_BAR; PG8_SCHED;
            PG8_LDB(B1, 1, 1); PG8_STAGE(PG8_SB(1, 0), b3, voffB);
            PG8_BAR; PG8_WAIT_L(0); PG8_MMA(0, 1, At, B1); PG8_BAR;
            PG8_LDA(At, 1, 1); PG8_STAGE(PG8_SA(1, 0), a3, voffA);
            PG8_BAR; PG8_WAIT_L(0); PG8_MMA(1, 0, At, B0); PG8_BAR; PG8_SCHED;
            PG8_STAGE(PG8_SB(1, 1), b3 + hstep, voffB);
            PG8_WAIT_V(6); PG8_BAR; PG8_MMA(1, 1, At, B1); PG8_BAR;
            }
        }
        if constexpr (ALIGN_EPI) { if (wr == 0) PG8_BAR; }
        if constexpr (!Epi::AFTER_DRAIN) { E(acc, cur, wr, wc, fr, fq); S.done(cur); }
        if (!has_next) break;
#pragma unroll
        for (int a = 0; a < 2; ++a)
#pragma unroll
            for (int b = 0; b < 2; ++b)
#pragma unroll
                for (int m = 0; m < 4; ++m)
#pragma unroll
                    for (int n = 0; n < 2; ++n) acc[a][b][m][n] = (f32x4){0.f, 0.f, 0.f, 0.f};
        cur = nxt; cA = nA; cB = nB; ++ui;
        if constexpr (ALIGN_EPI) { if (wr == 1) PG8_BAR; }
    }
    PG8_WAIT_V(0);
    if constexpr (!ALIGN_EPI) { if (wr == 0) PG8_BAR; }
    PG8_BAR;
    if constexpr (Epi::AFTER_DRAIN) { E.fused(acc, cur, wr, wc, fr, fq, lds, wid, lane); S.done(cur); }
#undef PG8_SA
#undef PG8_SB
#undef PG8_STAGE
#undef PG8_LDA
#undef PG8_LDB
#undef PG8_MMA
#undef PG8_WAIT_V
#undef PG8_WAIT_L
#undef PG8_BAR
#undef PG8_SCHED
}
}

constexpr int D = 1024, NBATCH = 4, SEQ = 4096, ML = NBATCH * SEQ, CTXL = 256, MC = NBATCH * CTXL, MT = ML + MC, FF = 2816, NFF = 2 * FF, PW = 1280, NMODV = 9 * D;
constexpr int NWAVES = 8;
constexpr float C2 = 0.125f * 1.4426950408889634f;
typedef unsigned short bf16;
typedef unsigned v4u __attribute__((ext_vector_type(4)));
typedef unsigned v2u __attribute__((ext_vector_type(2)));
typedef float f32x4 __attribute__((ext_vector_type(4)));
typedef float f32x16 __attribute__((ext_vector_type(16)));
typedef short bf16x8 __attribute__((ext_vector_type(8)));
typedef short s16x4 __attribute__((ext_vector_type(4)));
#define LAS __attribute__((address_space(3)))
#define LDS_WAIT() asm volatile("s_waitcnt lgkmcnt(0)" ::: "memory")
constexpr size_t MiB = 1u << 20;
constexpr size_t WS_MODS = 0;
constexpr size_t WS_ROPE = 384 * 1024;
constexpr size_t WS_BAR = 448 * 1024;
constexpr size_t WS_W = 1 * MiB;
constexpr size_t W_F1IN = 0, W_F1OUT = W_F1IN + (size_t)NFF * D * 2, W_IN = W_F1OUT + (size_t)D * FF * 2, W_OUT = W_IN + (size_t)PW * D * 2, W_F2IN = W_OUT + (size_t)D * D * 2,
                 W_F2OUT = W_F2IN + (size_t)NFF * D * 2, LW_BYTES = W_F2OUT + (size_t)D * FF * 2;
constexpr size_t WS_H = WS_W + 2 * LW_BYTES;
constexpr size_t WS_XN = WS_H + (size_t)MT * D * 4;
constexpr size_t WS_ACT = WS_XN + (size_t)MT * D * 2;
constexpr size_t WS_END = WS_ACT + (size_t)MT * FF * 2;
static_assert(WS_W + 2 * LW_BYTES == 76 * MiB, "weights");

__device__ __forceinline__ unsigned f2bf(float f) { unsigned u = __builtin_bit_cast(unsigned, f); return (u + 0x7fffu + ((u >> 16) & 1u)) >> 16; }
__device__ __forceinline__ unsigned pk2(float lo, float hi) { return f2bf(lo) | (f2bf(hi) << 16); }
__device__ __forceinline__ float bf_lo(unsigned w) { return __builtin_bit_cast(float, w << 16); }
__device__ __forceinline__ float bf_hi(unsigned w) { return __builtin_bit_cast(float, w & 0xffff0000u); }
__device__ __forceinline__ float wave_sum(float v) {
#pragma unroll
    for (int o = 1; o < 64; o <<= 1) v += __shfl_xor(v, o);
    return v;
}
struct Frame { LAS unsigned char* lds; int tid, lane, wave, G, bid; };

__device__ __forceinline__ int src_swiglu(int n) { return ((n & 255) >> 7) * FF + (n >> 8) * 128 + (n & 127); }
__device__ __forceinline__ int src_qkv(int n) { const int pn = n >> 8, bj = (n >> 7) & 1, wc = (n >> 5) & 3, i = n & 31;
    if (pn < 2) return n; if (pn < 4 || wc < 2) return pn * 256 + wc * 64 + bj * 32 + i; return 1152 + bj * 64 + (wc - 2) * 32 + i; }
__device__ __forceinline__ void transpose_item(const float* W, int N, bf16* WT, int ldk, int kofs, int srcc0, int n0, int k0, LAS float* scr, int lane) {
#pragma unroll 8
    for (int i = 0; i < 32; ++i) { const int kk = 2 * i + (lane >> 5); scr[kk * 33 + (lane & 31)] = W[(size_t)(k0 + kk) * N + srcc0 + (lane & 31)]; }
    LDS_WAIT(); asm volatile("" ::: "memory");
    const int c = lane & 7;
#pragma unroll
    for (int j = 0; j < 4; ++j) { const int n = (lane >> 3) + 8 * j; const LAS float* s = scr + (8 * c) * 33 + n;
        v4u o; o.x = pk2(s[0 * 33], s[1 * 33]); o.y = pk2(s[2 * 33], s[3 * 33]); o.z = pk2(s[4 * 33], s[5 * 33]); o.w = pk2(s[6 * 33], s[7 * 33]);
        *(v4u*)(WT + (size_t)(n0 + n) * ldk + kofs + k0 + 8 * c) = o; }
    LDS_WAIT(); asm volatile("" ::: "memory");
}
__device__ __forceinline__ void fold_item(const float* wpool, const float* pscale, const float* wout, bf16* WoT, int g, int n0, LAS float* scr, int lane) {
#pragma unroll
    for (int i = 0; i < 4; ++i) { const int e = lane + 64 * i;
        const int d = e >> 1, h = e & 1; f32x4 v = *(const f32x4*)(wout + (size_t)(g * 128 + d) * D + n0 + 4 * h); v = v * pscale[g * 128 + d]; *(LAS f32x4*)(scr + d * 8 + 4 * h) = v; }
    LDS_WAIT(); asm volatile("" ::: "memory");
#pragma unroll 1
    for (int cc = 0; cc < 2; ++cc) { const int c = lane + 64 * cc; const float* wp = wpool + ((size_t)g * 128 + c) * 128;
        float acc[8];
#pragma unroll
        for (int n = 0; n < 8; ++n) acc[n] = 0.f;
#pragma unroll 2
        for (int d4 = 0; d4 < 32; ++d4) { const f32x4 w = *(const f32x4*)(wp + 4 * d4);
#pragma unroll
            for (int dd = 0; dd < 4; ++dd) { const f32x4 a = *(const LAS f32x4*)(scr + (4 * d4 + dd) * 8), b = *(const LAS f32x4*)(scr + (4 * d4 + dd) * 8 + 4);
                acc[0] += w[dd] * a[0]; acc[1] += w[dd] * a[1]; acc[2] += w[dd] * a[2]; acc[3] += w[dd] * a[3]; acc[4] += w[dd] * b[0]; acc[5] += w[dd] * b[1]; acc[6] += w[dd] * b[2]; acc[7] += w[dd] * b[3]; } }
#pragma unroll
        for (int n = 0; n < 8; ++n) WoT[(size_t)(n0 + n) * D + g * 128 + c] = (bf16)f2bf(acc[n]); }
    LDS_WAIT(); asm volatile("" ::: "memory");
}
struct In { const float *x, *c, *ctx, *c_ctx, *w_mod, *b_mod, *norm_ffn1, *w_ffn1_in, *w_ffn1_out, *norm_mix, *w_in, *w_pool, *pool_scale, *sink, *w_out, *norm_ffn2, *w_ffn2_in, *w_ffn2_out, *norm_final; };

__device__ __forceinline__ void prologue(const Frame& F, const In& I, unsigned char* ws) {
    float* mods = (float*)(ws + WS_MODS);
    {
        LAS float* sl = (LAS float*)F.lds;
        LAS float* red = (LAS float*)(F.lds + 20480);
        bool have = false;
        for (int it = F.bid; it < 72; it += F.G) {
            if (!have) { for (int e = F.tid; e < 5 * D; e += 512) { const float v = (e < 4 * D) ? I.c[e] : I.c_ctx[e - 4 * D]; sl[e] = v / (1.0f + __expf(-v)); } have = true; __syncthreads(); }
            const int l = it / 36, cgp = it % 36; const float* W = I.w_mod + (size_t)l * D * NMODV + cgp * 256 + 4 * F.lane;
            f32x4 acc[5];
#pragma unroll
            for (int b = 0; b < 5; ++b) acc[b] = (f32x4){0.f, 0.f, 0.f, 0.f};
            const int kb = F.wave * 128;
#pragma unroll 8
            for (int k = 0; k < 128; ++k) { const f32x4 w = *(const f32x4*)(W + (size_t)(kb + k) * NMODV);
#pragma unroll
                for (int b = 0; b < 5; ++b) acc[b] += w * sl[b * D + kb + k]; }
#pragma unroll
            for (int b = 0; b < 5; ++b) *(LAS f32x4*)(red + (F.wave * 5 + b) * 256 + 4 * F.lane) = acc[b];
            __syncthreads();
            for (int e = F.tid; e < 5 * 256; e += 512) { const int b = e >> 8, cc = e & 255; float s = I.b_mod[(size_t)l * NMODV + cgp * 256 + cc];
#pragma unroll
                for (int w = 0; w < 8; ++w) s += red[(w * 5 + b) * 256 + cc];
                mods[((size_t)l * 5 + b) * NMODV + cgp * 256 + cc] = s; }
            __syncthreads();
        }
        __syncthreads();
    }
    LAS float* scr = (LAS float*)(F.lds + F.wave * 16384);
    const int gw = F.bid * NWAVES + F.wave, NGW = F.G * NWAVES;
    constexpr int I_FIN = (D / 64) * (NFF / 32), I_FOUT = (FF / 64) * (D / 32), I_IN = (D / 64) * (PW / 32), I_OUT = (512 / 64) * (D / 32), I_FOLD = 4 * (D / 8);
    constexpr int PER_L = 2 * I_FIN + 2 * I_FOUT + I_IN + I_OUT + I_FOLD, NITEMS = 2 * PER_L + 1;
    for (int it = gw; it < NITEMS; it += NGW) {
        if (it == 2 * PER_L) {
            float* rc = (float*)(ws + WS_ROPE); float* rs = rc + 1024;
            for (int f = 0; f < 16; ++f) { const float inv = powf(10000.0f, -(float)(2 * f) / 32.0f); const float a = (float)F.lane * inv; float s, c; sincosf(a, &s, &c); rc[F.lane * 16 + f] = c; rs[F.lane * 16 + f] = s; }
            continue;
        }
        const int l = it / PER_L; int r = it % PER_L; unsigned char* wl = ws + WS_W + (size_t)l * LW_BYTES;
        if (r < 2 * I_FIN) { const bool second = r >= I_FIN; if (second) r -= I_FIN; const float* W = (second ? I.w_ffn2_in : I.w_ffn1_in) + (size_t)l * D * NFF;
            const int nblk = NFF / 32, kb = r / nblk, nb = r % nblk; transpose_item(W, NFF, (bf16*)(wl + (second ? W_F2IN : W_F1IN)), D, 0, src_swiglu(32 * nb), 32 * nb, 64 * kb, scr, F.lane); continue; }
        r -= 2 * I_FIN;
        if (r < 2 * I_FOUT) { const bool second = r >= I_FOUT; if (second) r -= I_FOUT; const float* W = (second ? I.w_ffn2_out : I.w_ffn1_out) + (size_t)l * FF * D;
            const int nblk = D / 32, kb = r / nblk, nb = r % nblk; transpose_item(W, D, (bf16*)(wl + (second ? W_F2OUT : W_F1OUT)), FF, 0, 32 * nb, 32 * nb, 64 * kb, scr, F.lane); continue; }
        r -= 2 * I_FOUT;
        if (r < I_IN) { const float* W = I.w_in + (size_t)l * D * PW; const int nblk = PW / 32, kb = r / nblk, nb = r % nblk;
            transpose_item(W, PW, (bf16*)(wl + W_IN), D, 0, src_qkv(32 * nb), 32 * nb, 64 * kb, scr, F.lane); continue; }
        r -= I_IN;
        if (r < I_OUT) { const float* W = I.w_out + (size_t)l * D * D + (size_t)512 * D; const int nblk = D / 32, kb = r / nblk, nb = r % nblk;
            transpose_item(W, D, (bf16*)(wl + W_OUT), D, 512, 32 * nb, 32 * nb, 64 * kb, scr, F.lane); continue; }
        r -= I_OUT;
        { const int g = r / (D / 8), nb = r % (D / 8);
          fold_item(I.w_pool + (size_t)l * 4 * 128 * 128, I.pool_scale + (size_t)l * 512, I.w_out + (size_t)l * D * D, (bf16*)(wl + W_OUT), g, 8 * nb, scr, F.lane); }
    }
    { bf16* Hc = (bf16*)(ws + WS_H) + (size_t)ML * D; const int n4 = MC * D / 4;
      for (int e = F.bid * 512 + F.tid; e < n4; e += F.G * 512) { const f32x4 v = ((const f32x4*)I.ctx)[e]; v2u w; w.x = pk2(v.x, v.y); w.y = pk2(v.z, v.w); ((v2u*)Hc)[e] = w; } }
}

__device__ __forceinline__ void ld_row(const float* latf, const bf16* Hb, int m, int lane, f32x4 (&v)[4]) {
    if (latf != nullptr && m < ML) {
#pragma unroll
        for (int j = 0; j < 4; ++j) v[j] = *(const f32x4*)(latf + (size_t)m * D + 4 * lane + 256 * j);
    } else {
#pragma unroll
        for (int j = 0; j < 4; ++j) { const v2u w = *(const v2u*)(Hb + (size_t)m * D + 4 * lane + 256 * j); v[j] = (f32x4){bf_lo(w.x), bf_hi(w.x), bf_lo(w.y), bf_hi(w.y)}; } }
}
__device__ __forceinline__ void norm_phase(const Frame& F, const float* latf, bf16* Hb, bf16* XN, const float* g, const float* shift, const float* scale, int nrows, const bf16* slab, int nsplit) {
    const int gw = F.bid * NWAVES + F.wave, NGW = F.G * NWAVES; const int rpw = (ML + NGW - 1) / NGW;
    int m0 = gw * rpw, m1 = m0 + rpw; if (m1 > ML) m1 = ML; if (m0 > ML) m0 = ML;
    const int nctx = nrows - ML;
    int cur_b = -1; f32x4 gs[4], sh[4];
    for (int it = m0; it < m1 + 1; ++it) {
        int m = it;
        if (it == m1) { bool any = false; for (int r = gw; r < nctx; r += NGW) any = true; if (!any) break; m = ML + gw; }
        for (;; ) {
            const int b = m < ML ? (m >> 12) : 4;
            if (b != cur_b) { cur_b = b;
#pragma unroll
                for (int j = 0; j < 4; ++j) { const int col = 4 * F.lane + 256 * j; const f32x4 gv = *(const f32x4*)(g + col), sc = *(const f32x4*)(scale + (size_t)b * NMODV + col); gs[j] = gv * (sc + 1.0f); sh[j] = *(const f32x4*)(shift + (size_t)b * NMODV + col); } }
            f32x4 v[4]; float s = 0.f;
            ld_row(latf, Hb, m, F.lane, v);
            if (m >= ML && nsplit > 0) {
                const bf16* sp = slab + (size_t)(m - ML) * D + 4 * F.lane;
#pragma unroll 4
                for (int q = 0; q < nsplit; ++q) {
#pragma unroll
                    for (int j = 0; j < 4; ++j) { const v2u w = *(const v2u*)(sp + (size_t)q * (MC * D) + 256 * j); v[j] += (f32x4){bf_lo(w.x), bf_hi(w.x), bf_lo(w.y), bf_hi(w.y)}; } }
#pragma unroll
                for (int j = 0; j < 4; ++j) { v2u w; w.x = pk2(v[j].x, v[j].y); w.y = pk2(v[j].z, v[j].w); *(v2u*)(Hb + (size_t)m * D + 4 * F.lane + 256 * j) = w; }
            }
#pragma unroll
            for (int j = 0; j < 4; ++j) s += (v[j].x * v[j].x + v[j].y * v[j].y) + (v[j].z * v[j].z + v[j].w * v[j].w);
            const float rstd = 1.0f / sqrtf(wave_sum(s) * (1.0f / D) + 1e-6f);
            bf16* orow = XN + (size_t)m * D;
#pragma unroll
            for (int j = 0; j < 4; ++j) { const f32x4 o = v[j] * rstd * gs[j] + sh[j]; v2u w; w.x = pk2(o.x, o.y); w.y = pk2(o.z, o.w); *(v2u*)(orow + 4 * F.lane + 256 * j) = w; }
            if (m < ML) break;
            m += NGW; if (m >= ML + nctx) break;
        }
    }
}
__device__ __forceinline__ void final_norm(const Frame& F, const bf16* Hb, float* out, const float* g) {
    const int gw = F.bid * NWAVES + F.wave, NGW = F.G * NWAVES;
    f32x4 gv[4];
#pragma unroll
    for (int j = 0; j < 4; ++j) gv[j] = *(const f32x4*)(g + 4 * F.lane + 256 * j);
    for (int m = gw; m < ML; m += NGW) { f32x4 v[4]; float s = 0.f; ld_row(nullptr, Hb, m, F.lane, v);
#pragma unroll
        for (int j = 0; j < 4; ++j) s += (v[j].x * v[j].x + v[j].y * v[j].y) + (v[j].z * v[j].z + v[j].w * v[j].w);
        const float rstd = 1.0f / sqrtf(wave_sum(s) * (1.0f / D) + 1e-6f);
#pragma unroll
        for (int j = 0; j < 4; ++j) *(f32x4*)(out + (size_t)m * D + 4 * F.lane + 256 * j) = v[j] * rstd * gv[j]; }
}

constexpr int KROWB = 144;
constexpr int KBUF = 64 * KROWB;
__device__ __forceinline__ int crow(int r, int hi) { return (r & 3) + 8 * (r >> 2) + 4 * hi; }
__device__ __forceinline__ void attn_unit(const Frame& F, const bf16* QKV, bf16* MIX, const float* sink, int b, int kvh, int qt, bool isctx) {
    const int lane = F.lane, wid = F.wave, r32 = lane & 31, hi = lane >> 5, tid = F.tid;
    const int head = kvh * 4 + (wid >> 1), qh = wid & 1;
    const int qrow0 = isctx ? (ML + b * CTXL + qt * 64) : (b * SEQ + qt * 64);
    int lo = 0, nloc = 0;
    if (!isctx) { lo = qt - 2 < 0 ? 0 : qt - 2; const int hi_t = qt + 2 > 63 ? 63 : qt + 2; nloc = hi_t - lo + 1; }
    const int ntile = nloc + 4;
    bf16x8 qr[4];
    { const bf16* qp = QKV + (size_t)(qrow0 + 32 * qh + r32) * PW + 512 + head * 64 + hi * 8;
#pragma unroll
      for (int d0 = 0; d0 < 4; ++d0) qr[d0] = *(const bf16x8*)(qp + d0 * 16); }
    const int krow = tid >> 3, kch = tid & 7;
#define TILE_ROW(j) (((j) < nloc) ? (b * SEQ + (lo + (j)) * 64) : (ML + b * CTXL + ((j) - nloc) * 64))
#define LDK(j) (*(const v4u*)(QKV + (size_t)(TILE_ROW(j) + krow) * PW + 1024 + kvh * 64 + kch * 8))
#define LDV(j) (*(const v4u*)(QKV + (size_t)(TILE_ROW(j) + lane) * PW + 1152 + kvh * 64 + wid * 8))
    v4u kA = LDK(0), vA = LDV(0), kB = LDK(1), vB = LDV(1);
    float m_run = sink[head] * 1.4426950408889634f, l_run = (hi == 0) ? 1.0f : 0.0f;
    f32x16 o0 = {}, o1 = {};
    const int qpos = qt * 64 + 32 * qh + r32;
    auto stage = [&](int slot, const v4u& kreg, const v4u& vreg) __attribute__((always_inline)) {
        LAS unsigned char* kb = F.lds + slot * (2 * KBUF); LAS unsigned char* vb = kb + KBUF;
        *(LAS v4u*)(kb + krow * KROWB + kch * 16) = kreg;
        { LAS unsigned short* vt = (LAS unsigned short*)(vb + (wid * 8) * KROWB + lane * 2);
          vt[0 * (KROWB / 2)] = (unsigned short)(vreg.x & 0xffff); vt[1 * (KROWB / 2)] = (unsigned short)(vreg.x >> 16); vt[2 * (KROWB / 2)] = (unsigned short)(vreg.y & 0xffff); vt[3 * (KROWB / 2)] = (unsigned short)(vreg.y >> 16);
          vt[4 * (KROWB / 2)] = (unsigned short)(vreg.z & 0xffff); vt[5 * (KROWB / 2)] = (unsigned short)(vreg.z >> 16); vt[6 * (KROWB / 2)] = (unsigned short)(vreg.w & 0xffff); vt[7 * (KROWB / 2)] = (unsigned short)(vreg.w >> 16); }
    };
    auto compute = [&](int j, int slot) __attribute__((always_inline)) {
        LAS unsigned char* kb = F.lds + slot * (2 * KBUF); LAS unsigned char* vb = kb + KBUF;
        f32x16 p0 = {}, p1 = {};
#pragma unroll
        for (int d0 = 0; d0 < 4; ++d0) { const bf16x8 k0 = *(const LAS bf16x8*)(kb + r32 * KROWB + d0 * 32 + hi * 16), k1 = *(const LAS bf16x8*)(kb + (32 + r32) * KROWB + d0 * 32 + hi * 16);
            p0 = __builtin_amdgcn_mfma_f32_32x32x16_bf16(k0, qr[d0], p0, 0, 0, 0); p1 = __builtin_amdgcn_mfma_f32_32x32x16_bf16(k1, qr[d0], p1, 0, 0, 0); }
        if (j < nloc) { const int kbase = (lo + j) * 64 - qpos;
            const int dt = lo + j - qt;
            if (dt == -2 || dt == 2) {
#pragma unroll
                for (int r = 0; r < 16; ++r) { const int d0 = kbase + crow(r, hi), d1 = d0 + 32; if (d0 > 128 || d0 < -128) p0[r] = -1e30f; if (d1 > 128 || d1 < -128) p1[r] = -1e30f; } } }
        float mx = p0[0];
#pragma unroll
        for (int r = 1; r < 16; ++r) mx = fmaxf(mx, p0[r]);
#pragma unroll
        for (int r = 0; r < 16; ++r) mx = fmaxf(mx, p1[r]);
        mx = fmaxf(mx, __shfl_xor(mx, 32));
        const float mn = fmaxf(m_run, mx), alpha = __builtin_amdgcn_exp2f(m_run - mn); m_run = mn;
        float ps = 0.f;
#pragma unroll
        for (int r = 0; r < 16; ++r) { p0[r] = __builtin_amdgcn_exp2f(p0[r] - mn); p1[r] = __builtin_amdgcn_exp2f(p1[r] - mn); ps += p0[r] + p1[r]; }
        l_run = l_run * alpha + ps;
#pragma unroll
        for (int r = 0; r < 16; ++r) { o0[r] *= alpha; o1[r] *= alpha; }
#pragma unroll
        for (int c = 0; c < 4; ++c) {
            v4u pw;
            if (c == 0) { pw.x = pg8::cvt_pk_bf16(p0[0], p0[1]); pw.y = pg8::cvt_pk_bf16(p0[2], p0[3]); pw.z = pg8::cvt_pk_bf16(p0[4], p0[5]); pw.w = pg8::cvt_pk_bf16(p0[6], p0[7]); }
            else if (c == 1) { pw.x = pg8::cvt_pk_bf16(p0[8], p0[9]); pw.y = pg8::cvt_pk_bf16(p0[10], p0[11]); pw.z = pg8::cvt_pk_bf16(p0[12], p0[13]); pw.w = pg8::cvt_pk_bf16(p0[14], p0[15]); }
            else if (c == 2) { pw.x = pg8::cvt_pk_bf16(p1[0], p1[1]); pw.y = pg8::cvt_pk_bf16(p1[2], p1[3]); pw.z = pg8::cvt_pk_bf16(p1[4], p1[5]); pw.w = pg8::cvt_pk_bf16(p1[6], p1[7]); }
            else { pw.x = pg8::cvt_pk_bf16(p1[8], p1[9]); pw.y = pg8::cvt_pk_bf16(p1[10], p1[11]); pw.z = pg8::cvt_pk_bf16(p1[12], p1[13]); pw.w = pg8::cvt_pk_bf16(p1[14], p1[15]); }
            const bf16x8 pf = __builtin_bit_cast(bf16x8, pw);
#pragma unroll
            for (int dh = 0; dh < 2; ++dh) { const LAS unsigned char* vp = vb + (dh * 32 + r32) * KROWB + (16 * c + 4 * hi) * 2;
                const s16x4 a = *(const LAS s16x4*)vp, bq = *(const LAS s16x4*)(vp + 16);
                const bf16x8 vf = (bf16x8){a[0], a[1], a[2], a[3], bq[0], bq[1], bq[2], bq[3]};
                if (dh == 0) o0 = __builtin_amdgcn_mfma_f32_32x32x16_bf16(vf, pf, o0, 0, 0, 0); else o1 = __builtin_amdgcn_mfma_f32_32x32x16_bf16(vf, pf, o1, 0, 0, 0); }
        }
    };
    for (int j = 0, par = 0; j < ntile; j += 2, par ^= 2) {
        stage(par, kA, vA); if (j + 1 < ntile) stage(par + 1, kB, vB);
        asm volatile("s_waitcnt lgkmcnt(0)" ::: "memory"); __builtin_amdgcn_s_barrier(); asm volatile("" ::: "memory");
        if (j + 2 < ntile) { kA = LDK(j + 2); vA = LDV(j + 2); }
        if (j + 3 < ntile) { kB = LDK(j + 3); vB = LDV(j + 3); }
        compute(j, par); if (j + 1 < ntile) compute(j + 1, par + 1);
    }
#undef TILE_ROW
#undef LDK
#undef LDV
    const float lt = l_run + __shfl_xor(l_run, 32), inv = 1.0f / lt;
    bf16* op = MIX + (size_t)(qrow0 + 32 * qh + r32) * D + 512 + head * 64;
#pragma unroll
    for (int rq = 0; rq < 4; ++rq) { const int d = 8 * rq + 4 * hi;
        v2u w; w.x = pg8::cvt_pk_bf16(o0[4 * rq] * inv, o0[4 * rq + 1] * inv); w.y = pg8::cvt_pk_bf16(o0[4 * rq + 2] * inv, o0[4 * rq + 3] * inv); *(v2u*)(op + d) = w;
        w.x = pg8::cvt_pk_bf16(o1[4 * rq] * inv, o1[4 * rq + 1] * inv); w.y = pg8::cvt_pk_bf16(o1[4 * rq + 2] * inv, o1[4 * rq + 3] * inv); *(v2u*)(op + 32 + d) = w; }
    asm volatile("s_waitcnt lgkmcnt(0)" ::: "memory"); __builtin_amdgcn_s_barrier(); asm volatile("" ::: "memory");
}
template <int W> __device__ __forceinline__ void pool_seg(const bf16* QKV, bf16* MIX, int base, int Tn, int t0, int cc) {
    v4u rr[W + 7];
#pragma unroll
    for (int i = 0; i < W + 7; ++i) { const int tt = t0 - W / 2 + i; rr[i] = (v4u){0u, 0u, 0u, 0u}; if (tt >= 0 && tt < Tn) rr[i] = *(const v4u*)(QKV + (size_t)(base + tt) * PW + cc); }
#pragma unroll
    for (int r = 0; r < 8; ++r) { const int t = t0 + r; int lo = t - W / 2, hi = t + W - W / 2; if (lo < 0) lo = 0; if (hi > Tn) hi = Tn;
        float s[8];
#pragma unroll
        for (int i = 0; i < 8; ++i) s[i] = 0.f;
#pragma unroll
        for (int i = 0; i < W; ++i) { const v4u v = rr[r + i];
            s[0] += bf_lo(v.x); s[1] += bf_hi(v.x); s[2] += bf_lo(v.y); s[3] += bf_hi(v.y); s[4] += bf_lo(v.z); s[5] += bf_hi(v.z); s[6] += bf_lo(v.w); s[7] += bf_hi(v.w); }
        const float inv = 1.0f / (float)(hi - lo); const v4u u = rr[r + W / 2];
        v4u o; o.x = pk2(s[0] * inv - bf_lo(u.x), s[1] * inv - bf_hi(u.x)); o.y = pk2(s[2] * inv - bf_lo(u.y), s[3] * inv - bf_hi(u.y));
        o.z = pk2(s[4] * inv - bf_lo(u.z), s[5] * inv - bf_hi(u.z)); o.w = pk2(s[6] * inv - bf_lo(u.w), s[7] * inv - bf_hi(u.w));
        *(v4u*)(MIX + (size_t)(base + t) * D + cc) = o; }
}
__device__ __forceinline__ void pool_item(const Frame& F, const bf16* QKV, bf16* MIX, int r0) {
    int base, Tn; if (r0 < ML) { base = r0 & ~(SEQ - 1); Tn = SEQ; } else { base = ML + ((r0 - ML) & ~(CTXL - 1)); Tn = CTXL; }
    const int g = F.wave >> 1, cc = (g * 16 + (F.wave & 1) * 8 + (F.lane & 7)) * 8, t0 = (r0 - base) + (F.lane >> 3) * 8;
    if (g == 0) pool_seg<2>(QKV, MIX, base, Tn, t0, cc); else if (g == 1) pool_seg<4>(QKV, MIX, base, Tn, t0, cc); else if (g == 2) pool_seg<8>(QKV, MIX, base, Tn, t0, cc); else pool_seg<16>(QKV, MIX, base, Tn, t0, cc);
}
__device__ __forceinline__ void mixer_phase(const Frame& F, const bf16* QKV, bf16* MIX, const float* sink, bool do_ctx) {
    const int n_lat = NBATCH * 2 * 64, n_ctx = do_ctx ? NBATCH * 2 * 4 : 0, n_pool = (do_ctx ? MT : ML) / 64, total = n_lat + n_ctx + n_pool;
    for (int L = F.bid; L < total; L += F.G) {
        if (L < n_lat) { const int qt = L & 63, kvh = (L >> 6) & 1, b = L >> 7; attn_unit(F, QKV, MIX, sink, b, kvh, qt, false); }
        else if (L < n_lat + n_ctx) { const int u = L - n_lat; const int qt = u & 3, kvh = (u >> 2) & 1, b = u >> 3; attn_unit(F, QKV, MIX, sink, b, kvh, qt, true); }
        else pool_item(F, QKV, MIX, (L - n_lat - n_ctx) * 64);
    }
}

#define XB_TMO      128
#define XB_XCNT(j)  (256  + 64 * (j))
#define XB_XSUB(j)  (1280 + 64 * (j))
#define XB_XGEN(j)  (2304 + 64 * (j))
#define XB_TOP      3328
#define XB_TOPGEN   3392
#define XCD_BAR_WORDS 3456
#define XB_SPIN_CAP (1u << 18)

__device__ __forceinline__ unsigned xb_ld(unsigned* p)              { return __hip_atomic_load(p, __ATOMIC_RELAXED, __HIP_MEMORY_SCOPE_AGENT); }
__device__ __forceinline__ unsigned xb_add(unsigned* p, unsigned v) { return __hip_atomic_fetch_add(p, v, __ATOMIC_RELAXED, __HIP_MEMORY_SCOPE_AGENT); }
__device__ __forceinline__ unsigned xb_xcc_id() { return (unsigned)__builtin_amdgcn_s_getreg((3 << 11) | 20) & 0xFu; }
#define XB_SPIN(cond, bar) do { unsigned _sp = 0; while (cond) { __builtin_amdgcn_s_sleep(1); \
    if ((++_sp & 255u) == 0u) { if (xb_ld(&(bar)[XB_TMO])) break; if (_sp > XB_SPIN_CAP) { atomicAdd(&(bar)[XB_TMO], 1u); break; } } } } while (0)

struct XcdBarrier {
    unsigned* bar; unsigned x;
    volatile LAS unsigned* st;
};

__device__ __forceinline__ XcdBarrier xcd_barrier_post(unsigned* bar, volatile LAS unsigned* st) {
    XcdBarrier b; b.bar = bar; b.x = xb_xcc_id(); b.st = st;
    if (threadIdx.x == 0) (void)xb_add(&bar[XB_XCNT(b.x)], 1u);
    return b;
}
__device__ __forceinline__ void xcd_barrier_complete(unsigned* bar, unsigned x, unsigned& nloc, unsigned& nx) {
    const unsigned G = gridDim.x * gridDim.y * gridDim.z;
    unsigned sum, cnt, mine, sp = 0u;
    for (;;) {
        sum = 0u; cnt = 0u; mine = 0u;
#pragma unroll
        for (unsigned j = 0; j < 16; ++j) { const unsigned c = xb_ld(&bar[XB_XCNT(j)]); sum += c; cnt += (c > 0u) ? 1u : 0u; mine = (j == x) ? c : mine; }
        if (sum == G) break;
        __builtin_amdgcn_s_sleep(1);
        if ((++sp & 255u) == 0u) { if (xb_ld(&bar[XB_TMO])) break; if (sp > XB_SPIN_CAP) { atomicAdd(&bar[XB_TMO], 1u); break; } }
    }
    nloc = mine > 0u ? mine : 1u; nx = cnt > 0u ? cnt : 1u;
}

__device__ __forceinline__ void xcd_barrier(const XcdBarrier& b) {
    asm volatile("s_waitcnt vmcnt(0)" ::: "memory");
    __syncthreads();
    if (threadIdx.x == 0) {
        unsigned* bar = b.bar;
        __builtin_amdgcn_s_waitcnt(0);
        unsigned nloc = b.st[0], nx = b.st[1];
        if (nloc == 0u) { xcd_barrier_complete(bar, b.x, nloc, nx); b.st[0] = nloc; b.st[1] = nx; }
        const unsigned old = xb_add(&bar[XB_XSUB(b.x)], 1u);
        const unsigned gen = old / nloc;
        if (old + 1u == (gen + 1u) * nloc) {
            __builtin_amdgcn_fence(__ATOMIC_RELEASE, "agent");
            asm volatile("s_waitcnt vmcnt(0)" ::: "memory");
            const unsigned og = xb_add(&bar[XB_TOP], 1u);
            const unsigned tg = og / nx;
            if (og + 1u == (tg + 1u) * nx) xb_add(&bar[XB_TOPGEN], 1u);
            else XB_SPIN(xb_ld(&bar[XB_TOPGEN]) == tg, bar);
            __builtin_amdgcn_fence(__ATOMIC_ACQUIRE, "agent");
            xb_add(&bar[XB_XGEN(b.x)], 1u);
            asm volatile("s_waitcnt vmcnt(0)" ::: "memory");
        } else {
            XB_SPIN(xb_ld(&bar[XB_XGEN(b.x)]) == gen, bar);
            __builtin_amdgcn_fence(__ATOMIC_ACQUIRE, "agent");
            asm volatile("s_waitcnt vmcnt(0)" ::: "memory");
        }
    }
    __syncthreads();
}
#ifndef XP
#define XP 0
#endif
#define GSYNC() do { xcd_barrier(xbar); if (XP == 1) xcd_barrier(xbar); } while (0)
#define REPS(x) for (int rep_ = 0; rep_ < ((XP == (x)) ? 2 : 1); ++rep_)
#ifndef PHASES
#define PHASES 0xFFFF
#endif
#define PH(n) if (PHASES & (1 << (n)))
constexpr int LDS_BYTES = 147456;
struct Args { const void* p[21]; };
__device__ __forceinline__ const float* argf(const Args& a, int k) { asm volatile("" : "+s"(k)); return (const float*)a.p[k]; }
__device__ __forceinline__ unsigned char* argws(const Args& a) { int k = 20; asm volatile("" : "+s"(k)); return (unsigned char*)a.p[k]; }
#define MKFRAME() Frame F; F.lds = (LAS unsigned char*)lds; F.tid = threadIdx.x; asm volatile("" : "+v"(F.tid)); F.lane = F.tid & 63; F.wave = __builtin_amdgcn_readfirstlane(F.tid >> 6); F.G = gridDim.x; F.bid = blockIdx.x
__global__ void __launch_bounds__(NWAVES * 64, 2) fwd_megakernel(Args args) {
    extern __shared__ __attribute__((aligned(16))) unsigned char lds[];
    cg::grid_group grid = cg::this_grid();
    volatile LAS unsigned* xst = (volatile LAS unsigned*)((LAS unsigned char*)lds + 131072 + 64);
    if (threadIdx.x < 2) xst[threadIdx.x] = 0u;
    __syncthreads();
    const XcdBarrier xbar = xcd_barrier_post((unsigned*)(argws(args) + WS_BAR), xst);
    REPS(5) PH(0) { MKFRAME();
        In I; I.x = argf(args, 0); I.c = argf(args, 1); I.ctx = argf(args, 2); I.c_ctx = argf(args, 3); I.w_mod = argf(args, 4); I.b_mod = argf(args, 5); I.norm_ffn1 = argf(args, 6); I.w_ffn1_in = argf(args, 7); I.w_ffn1_out = argf(args, 8);
        I.norm_mix = argf(args, 9); I.w_in = argf(args, 10); I.w_pool = argf(args, 11); I.pool_scale = argf(args, 12); I.sink = argf(args, 13); I.w_out = argf(args, 14); I.norm_ffn2 = argf(args, 15); I.w_ffn2_in = argf(args, 16); I.w_ffn2_out = argf(args, 17); I.norm_final = argf(args, 18);
        prologue(F, I, argws(args)); }
    GSYNC();
    if (gridDim.x == 0x7fffffffu) grid.sync();
#pragma unroll 1
    for (int st = 0; st < 20; ++st) {
        const int l = st >= 10 ? 1 : 0, k = st - 10 * l;
        if (k == 0 || k == 3 || k == 7) { REPS(3) PH(1) { MKFRAME(); unsigned char* ws = argws(args); bf16* H = (bf16*)(ws + WS_H);
            const int j = (k == 0) ? 0 : (k == 3 ? 3 : 6); const float* ml = (const float*)(ws + WS_MODS) + (size_t)l * 5 * NMODV + j * D;
            const float* gw = argf(args, k == 0 ? 6 : (k == 3 ? 9 : 15)) + l * D;
            norm_phase(F, (st == 0) ? argf(args, 0) : nullptr, H, (bf16*)(ws + WS_XN), gw, ml, ml + D, (st == 17) ? ML : MT, (const bf16*)argf(args, 19), (st == 0 || st == 17) ? 0 : (k == 7 ? 4 : 11)); } }
        else if (k == 1 || k == 8) { REPS(6) PH(2) { unsigned char* ws = argws(args); unsigned char* wl = ws + WS_W + (size_t)l * LW_BYTES; const int nm = ((st == 18) ? ML : MT) / 256;
            pg8::Gemm g{(const bf16*)(ws + WS_XN), (const bf16*)(wl + (k == 1 ? W_F1IN : W_F2IN)), MT, NFF, D}; pg8::Sched<NFF / 256> S{nm, D / 64, (int)gridDim.x, (int)blockIdx.x, nm * (NFF / 256), 0, 1, 2};
            pg8::EpiSwiglu E{(bf16*)(ws + WS_ACT), FF}; pg8::gemm_phase<pg8::EpiSwiglu, pg8::Sched<NFF / 256>, true, true>((LAS unsigned char*)lds, g, S, E); } }
        else if (k == 2 || k == 6 || k == 9) { REPS(7) PH(3) { unsigned char* ws = argws(args); unsigned char* wl = ws + WS_W + (size_t)l * LW_BYTES; pg8::bf16_t* H = (pg8::bf16_t*)(ws + WS_H);
            const int j = (k == 2) ? 2 : (k == 6 ? 5 : 8); const float* gate = (const float*)(ws + WS_MODS) + (size_t)l * 5 * NMODV + j * D;
            const bool wo = (k == 6); const int nctx = (l == 1 && k != 2) ? 0 : 16; const bool nosplit = (XP == 2);
            pg8::Gemm g{(const bf16*)(ws + (wo ? WS_XN : WS_ACT)), (const bf16*)(wl + (k == 2 ? W_F1OUT : (wo ? W_OUT : W_F2OUT))), MT, D, wo ? D : FF};
            pg8::Sched<D / 256> S{ML / 256, (wo ? D : FF) / 64, (int)gridDim.x, (int)blockIdx.x, (ML / 256) * (D / 256), nosplit ? 0 : nctx, wo ? 4 : 11, 4}; if (nosplit) { S.nM = ML / 256 + nctx / 4; S.nmain = S.nM * 4; }
            pg8::EpiRes E{(st == 2 && rep_ == 0) ? argf(args, 0) : nullptr, H, gate, NMODV, (rep_ == 1) ? 0.0f : (wo ? 1.0f : 0.5f), (pg8::bf16_t*)argf(args, 19)}; pg8::gemm_phase<pg8::EpiRes, pg8::Sched<D / 256>, true, true>((LAS unsigned char*)lds, g, S, E); } }
        else if (k == 4) { REPS(8) PH(5) { unsigned char* ws = argws(args); unsigned char* wl = ws + WS_W + (size_t)l * LW_BYTES; const float* ropeC = (const float*)(ws + WS_ROPE);
            pg8::Gemm g{(const bf16*)(ws + WS_XN), (const bf16*)(wl + W_IN), MT, PW, D}; pg8::Sched<PW / 256> S{MT / 256, D / 64, (int)gridDim.x, (int)blockIdx.x, (MT / 256) * (PW / 256), 0, 1, 2};
            pg8::EpiQKV E{(bf16*)(ws + WS_ACT), ropeC, ropeC + 1024, C2}; pg8::gemm_phase<pg8::EpiQKV, pg8::Sched<PW / 256>, true, true>((LAS unsigned char*)lds, g, S, E); } }
        else { REPS(4) PH(6) { MKFRAME(); unsigned char* ws = argws(args); mixer_phase(F, (const bf16*)(ws + WS_ACT), (bf16*)(ws + WS_XN), argf(args, 13) + l * 8, l == 0); } }
        GSYNC();
    }
    PH(11) { MKFRAME(); unsigned char* ws = argws(args); int k = 19; asm volatile("" : "+s"(k)); final_norm(F, (const bf16*)(ws + WS_H), (float*)args.p[k], argf(args, 18)); }
}

extern "C" void kernel_launch(void* const* d_in, const int* in_sizes, int n_in, void* d_out, int out_size, void* d_ws, size_t ws_size, hipStream_t stream) {
    static int grid_blocks = 0;
    if (grid_blocks == 0) {
        if (n_in != 19 || out_size != ML * D || ws_size < WS_END) { fprintf(stderr, "kernel_launch: unexpected shapes (n_in %d, out %d, ws %zu < %zu)\n", n_in, out_size, ws_size, (size_t)WS_END); grid_blocks = -1; return; }
        int dev = 0, cus = 0, per_cu = 0;
        (void)hipGetDevice(&dev); (void)hipDeviceGetAttribute(&cus, hipDeviceAttributeMultiprocessorCount, dev);
        if (hipFuncSetAttribute((const void*)fwd_megakernel, hipFuncAttributeMaxDynamicSharedMemorySize, LDS_BYTES) != hipSuccess) { fprintf(stderr, "kernel_launch: hipFuncSetAttribute failed\n"); grid_blocks = -1; return; }
        if (hipOccupancyMaxActiveBlocksPerMultiprocessor(&per_cu, (const void*)fwd_megakernel, NWAVES * 64, LDS_BYTES) != hipSuccess || per_cu < 1) { fprintf(stderr, "kernel_launch: occupancy query gave %d\n", per_cu); per_cu = 1; }
        (void)hipGetLastError();
        grid_blocks = cus * per_cu;
    }
    if (grid_blocks < 0) return;
    if (hipMemsetAsync((char*)d_ws + WS_BAR, 0, XCD_BAR_WORDS * 4, stream) != hipSuccess) { fprintf(stderr, "kernel_launch: memset failed\n"); return; }
    Args a{};
    for (int i = 0; i < 19; ++i) a.p[i] = d_in[i];
    a.p[19] = d_out; a.p[20] = d_ws;
    void* kargs[] = {&a};
    hipError_t e = hipLaunchCooperativeKernel((const void*)fwd_megakernel, dim3(grid_blocks), dim3(NWAVES * 64), kargs, LDS_BYTES, stream);
    if (e != hipSuccess) fprintf(stderr, "kernel_launch: cooperative launch failed: %s (grid %d)\n", hipGetErrorString(e), grid_blocks);
}
```

```cpp
#include <hip/hip_runtime.h>
#include <hip/hip_cooperative_groups.h>
#include <cstdio>
#include <cstdint>
namespace cg = cooperative_groups;
namespace pg8 {
#define PG8_LAS __attribute__((address_space(3)))
typedef unsigned short bf16_t;
typedef short bf16x8 __attribute__((ext_vector_type(8)));
typedef float f32x4 __attribute__((ext_vector_type(4)));
typedef unsigned u32x4 __attribute__((ext_vector_type(4)));
constexpr int BM = 256, BK = 64, HALF = 128, HTB = HALF * BK * 2  , STAGE_BYTES = 8 * HTB, NXCD = 8, WGM = 8;

__host__ __device__ __forceinline__ int lds_byte(int r, int c) { const int st = (r >> 4) * 2 + (c >> 5), rr = r & 15, cc = c & 31, ob = rr * 64 + cc * 2; return st * 1024 + (ob ^ (((ob >> 9) & 1) << 5)); }
__host__ __device__ __forceinline__ void stage_rc(int b, int& R, int& C) { const int st = b / 1024, sb = b % 1024, swz = sb ^ (((sb >> 9) & 1) << 5); R = (st >> 1) * 16 + swz / 64; C = (st & 1) * 32 + (swz % 64) / 2; }
__host__ __device__ __forceinline__ int perm32(int rho) { const int n = rho >> 4, i = rho & 15; return 8 * (i >> 2) + 4 * n + (i & 3); }

struct Unit { int pm, pn, k0, nk, fl; };
struct Gemm { const bf16_t* A; const bf16_t* Bt; int M, N, K; };
typedef float f32x2_t __attribute__((ext_vector_type(2))); typedef __bf16 bf16x2_t __attribute__((ext_vector_type(2)));
__device__ __forceinline__ unsigned cvt_pk_bf16(float lo, float hi) { f32x2_t v = {lo, hi}; bf16x2_t b = __builtin_convertvector(v, bf16x2_t); return __builtin_bit_cast(unsigned, b); }
typedef float f32x2 __attribute__((ext_vector_type(2)));

template <int NN> __device__ __forceinline__ void tile_of(int L, int nM, int& pm, int& pn) {
    static_assert(NXCD == 8 && WGM == 8, "shifts below");
    const int nwg = nM * NN; int wgid = L;
    { const int q = nwg >> 3, r = nwg & 7, xcd = wgid & 7, off = wgid >> 3; wgid = (xcd < r ? xcd * (q + 1) : r * (q + 1) + (xcd - r) * q) + off; }
    constexpr int nig = WGM * NN; const int gid = wgid / nig, rem = wgid - gid * nig, fm = gid * WGM, gsz = (nM - fm) < WGM ? (nM - fm) : WGM;
    if (gsz == WGM) { pm = fm + (rem & 7); pn = rem >> 3; } else { pm = fm + rem % gsz; pn = rem / gsz; }
}
template <int NN> struct Sched {
    int nM, nkt, G, c, nmain, nctxu, nsplit, kper;
    __device__ __forceinline__ bool next(int i, Unit& u) const {
        const int L = i * G + c;
        if (L < nmain) { tile_of<NN>(L, nM, u.pm, u.pn); u.k0 = 0; u.nk = nkt; u.fl = 0; return true; }
        const int s = L - nmain; if (s >= nctxu * nsplit) return false;
        const int uu = s / nsplit, ks = s - uu * nsplit; u.pm = nM + uu / NN; u.pn = uu % NN; u.k0 = ks * kper; u.nk = kper; u.fl = 1; return true;
    }
    __device__ __forceinline__ void a_ready(const Unit&) const {}
    __device__ __forceinline__ void done(const Unit&) const {}
};
__device__ __forceinline__ float silu_mul(float a, float b) { const float e = __builtin_amdgcn_exp2f(a * -1.4426950408889634f); return a * b * __builtin_amdgcn_rcpf(1.0f + e); }
struct EpiSwiglu {
    static constexpr bool PERM = true, AFTER_DRAIN = false;
    bf16_t* O; int ldc;
    __device__ __forceinline__ void operator()(const f32x4 (&acc)[2][2][4][2], const Unit& u, int wr, int wc, int fr, int fq) const {
        const int row0 = u.pm * BM + wr * 64 + fr, col0 = u.pn * HALF + wc * 32 + 8 * fq;
#pragma unroll
        for (int ai = 0; ai < 2; ++ai)
#pragma unroll
            for (int m = 0; m < 4; ++m) { bf16_t* rowp = O + (size_t)(row0 + ai * HALF + m * 16) * ldc + col0;
                const f32x4 a0 = acc[ai][0][m][0], a1 = acc[ai][0][m][1], b0 = acc[ai][1][m][0], b1 = acc[ai][1][m][1];
                u32x4 w; w.x = cvt_pk_bf16(silu_mul(a0[0], b0[0]), silu_mul(a0[1], b0[1])); w.y = cvt_pk_bf16(silu_mul(a0[2], b0[2]), silu_mul(a0[3], b0[3]));
                w.z = cvt_pk_bf16(silu_mul(a1[0], b1[0]), silu_mul(a1[1], b1[1])); w.w = cvt_pk_bf16(silu_mul(a1[2], b1[2]), silu_mul(a1[3], b1[3]));
                *(u32x4*)rowp = w; }
    }
};
struct EpiRes {
    static constexpr bool PERM = true, AFTER_DRAIN = false;
    const float* basef; bf16_t* Hb; const float* gate; int gstride; float coef; bf16_t* slab;
    __device__ __forceinline__ void operator()(const f32x4 (&acc)[2][2][4][2], const Unit& u, int wr, int wc, int fr, int fq) const {
        const int bidx = u.pm < 64 ? (u.pm >> 4) : 4; const float* gp = gate + (size_t)bidx * gstride;
        const int col0 = u.pn * BM + wc * 32 + 8 * fq;
        f32x4 gv[2][2];
#pragma unroll
        for (int bj = 0; bj < 2; ++bj)
#pragma unroll
            for (int n = 0; n < 2; ++n) gv[bj][n] = *(const f32x4*)(gp + col0 + bj * HALF + n * 4) * coef;
        const bool f32base = (basef != nullptr) && (u.pm < 64);
#pragma unroll
        for (int ai = 0; ai < 2; ++ai)
#pragma unroll
            for (int m = 0; m < 4; ++m) { const size_t off = (size_t)(u.pm * BM + ai * HALF + wr * 64 + m * 16 + fr) * 1024 + col0;
#pragma unroll
                for (int bj = 0; bj < 2; ++bj) { const size_t o = off + bj * HALF; const f32x4 v0 = acc[ai][bj][m][0] * gv[bj][0], v1 = acc[ai][bj][m][1] * gv[bj][1];
                    if (u.fl) { u32x4 w; w.x = cvt_pk_bf16(v0[0], v0[1]); w.y = cvt_pk_bf16(v0[2], v0[3]); w.z = cvt_pk_bf16(v1[0], v1[1]); w.w = cvt_pk_bf16(v1[2], v1[3]);
                        *(u32x4*)(slab + (size_t)(u.k0 >> 2) * (1024 * 1024) + (o - (size_t)16384 * 1024)) = w; }
                    else { f32x4 b0, b1;
                        if (f32base) { b0 = *(const f32x4*)(basef + o); b1 = *(const f32x4*)(basef + o + 4); }
                        else { const u32x4 w = *(const u32x4*)(Hb + o); b0 = (f32x4){__builtin_bit_cast(float, w.x << 16), __builtin_bit_cast(float, w.x & 0xffff0000u), __builtin_bit_cast(float, w.y << 16), __builtin_bit_cast(float, w.y & 0xffff0000u)};
                            b1 = (f32x4){__builtin_bit_cast(float, w.z << 16), __builtin_bit_cast(float, w.z & 0xffff0000u), __builtin_bit_cast(float, w.w << 16), __builtin_bit_cast(float, w.w & 0xffff0000u)}; }
                        b0 += v0; b1 += v1; u32x4 w; w.x = cvt_pk_bf16(b0[0], b0[1]); w.y = cvt_pk_bf16(b0[2], b0[3]); w.z = cvt_pk_bf16(b1[0], b1[1]); w.w = cvt_pk_bf16(b1[2], b1[3]);
                        *(u32x4*)(Hb + o) = w; } } }
    }
};
struct EpiQKV {
    static constexpr bool PERM = true, AFTER_DRAIN = false;
    bf16_t* O; const float* ropeC; const float* ropeS; float qscale;
    __device__ __forceinline__ void operator()(const f32x4 (&acc)[2][2][4][2], const Unit& u, int wr, int wc, int fr, int fq) const {
        const int row0 = u.pm * BM + wr * 64 + fr; const bool latent = u.pm < 64;
        if (u.pn < 2 || (u.pn == 4 && wc >= 2)) {
#pragma unroll
            for (int bj = 0; bj < 2; ++bj) { const int col = (u.pn < 2) ? (u.pn * BM + bj * HALF + wc * 32 + 8 * fq) : (1152 + bj * 64 + (wc - 2) * 32 + 8 * fq);
#pragma unroll
                for (int ai = 0; ai < 2; ++ai)
#pragma unroll
                    for (int m = 0; m < 4; ++m) { const f32x4 v0 = acc[ai][bj][m][0], v1 = acc[ai][bj][m][1];
                        u32x4 w; w.x = cvt_pk_bf16(v0[0], v0[1]); w.y = cvt_pk_bf16(v0[2], v0[3]); w.z = cvt_pk_bf16(v1[0], v1[1]); w.w = cvt_pk_bf16(v1[2], v1[3]);
                        *(u32x4*)(O + (size_t)(row0 + ai * HALF + m * 16) * 1280 + col) = w; } }
        } else {
            const int dst1 = u.pn * BM + wc * 64 + 8 * fq; const float sc = (u.pn < 4) ? qscale : 1.0f; const int fb = 8 * (fq & 1);
#pragma unroll
            for (int ai = 0; ai < 2; ++ai)
#pragma unroll
                for (int m = 0; m < 4; ++m) { const int r = row0 + ai * HALF + m * 16; const int t = r & 4095; const int pos = (fq < 2) ? (t >> 6) : (t & 63);
                    f32x4 c0 = (f32x4){1.f, 1.f, 1.f, 1.f}, c1 = c0, s0 = (f32x4){0.f, 0.f, 0.f, 0.f}, s1 = s0;
                    if (latent) { c0 = *(const f32x4*)(ropeC + pos * 16 + fb); c1 = *(const f32x4*)(ropeC + pos * 16 + fb + 4); s0 = *(const f32x4*)(ropeS + pos * 16 + fb); s1 = *(const f32x4*)(ropeS + pos * 16 + fb + 4); }
                    const f32x4 xa0 = acc[ai][0][m][0], xa1 = acc[ai][0][m][1], xb0 = acc[ai][1][m][0], xb1 = acc[ai][1][m][1];
                    const f32x4 y10 = (xa0 * c0 - xb0 * s0) * sc, y11 = (xa1 * c1 - xb1 * s1) * sc, y20 = (xb0 * c0 + xa0 * s0) * sc, y21 = (xb1 * c1 + xa1 * s1) * sc;
                    u32x4 w1, w2; w1.x = cvt_pk_bf16(y10[0], y10[1]); w1.y = cvt_pk_bf16(y10[2], y10[3]); w1.z = cvt_pk_bf16(y11[0], y11[1]); w1.w = cvt_pk_bf16(y11[2], y11[3]);
                    w2.x = cvt_pk_bf16(y20[0], y20[1]); w2.y = cvt_pk_bf16(y20[2], y20[3]); w2.z = cvt_pk_bf16(y21[0], y21[1]); w2.w = cvt_pk_bf16(y21[2], y21[3]);
                    bf16_t* rp = O + (size_t)r * 1280 + dst1; *(u32x4*)rp = w1; *(u32x4*)(rp + 32) = w2; }
        }
    }
};

template <class Epi, class Sched, bool ALIGN_EPI = false, bool SP2 = false>
__device__ __forceinline__ void gemm_phase(PG8_LAS unsigned char* lds, const Gemm g, const Sched& S, const Epi& E) {
    int tid_ = threadIdx.x; asm volatile("" : "+v"(tid_));
    const int tid = tid_, wid = __builtin_amdgcn_readfirstlane(tid >> 6), lane = tid & 63, wr = wid >> 2, wc = wid & 3, fr = lane & 15, fq = lane >> 4;
    const int K = g.K;
    unsigned voffA[2], voffB[2];
#pragma unroll
    for (int i = 0; i < 2; ++i) { int R, C; stage_rc(tid * 16 + i * 8192, R, C); const int Rb = Epi::PERM ? ((R & ~31) + perm32(R & 31)) : R;
        voffA[i] = (unsigned)(R * K + C) * 2u; voffB[i] = (unsigned)(Rb * K + C) * 2u; }
    const size_t kstep = (size_t)(BK * 2);
    const size_t hstep = (size_t)HALF * K * 2;
    const size_t tstep = 2 * hstep;
    const unsigned ldsw = (unsigned)wid * 1024u;
    const int aoff = lds_byte(wr * 64 + fr, fq * 8), boff = lds_byte(wc * 32 + fr, fq * 8);
#define PG8_SA(b, h) (((b) * 2 + (h)) * HTB)
#define PG8_SB(b, h) ((4 + (b) * 2 + (h)) * HTB)
#define PG8_STAGE(bufoff, gbase, voff) do { _Pragma("unroll") for (int _i = 0; _i < 2; ++_i) \
        __builtin_amdgcn_global_load_lds((const unsigned*)((const char*)(gbase) + (voff)[_i]), (PG8_LAS unsigned*)(lds + (bufoff) + ldsw + _i * 8192), 16, 0, 0); } while (0)
#define PG8_LDA(dst, b, h) do { _Pragma("unroll") for (int m = 0; m < 4; ++m) _Pragma("unroll") for (int k = 0; k < 2; ++k) dst[m][k] = *(const PG8_LAS bf16x8*)(lds + PG8_SA(b, h) + aoff + m * 2048 + k * 1024); } while (0)
#define PG8_LDB(dst, b, h) do { _Pragma("unroll") for (int n = 0; n < 2; ++n) _Pragma("unroll") for (int k = 0; k < 2; ++k) dst[n][k] = *(const PG8_LAS bf16x8*)(lds + PG8_SB(b, h) + boff + n * 2048 + k * 1024); } while (0)
#define PG8_MMA(ai, bj, At, Bt) do { __builtin_amdgcn_s_setprio(1); _Pragma("unroll") for (int m = 0; m < 4; ++m) _Pragma("unroll") for (int n = 0; n < 2; ++n) _Pragma("unroll") for (int k = 0; k < 2; ++k) \
        acc[ai][bj][m][n] = __builtin_amdgcn_mfma_f32_16x16x32_bf16(Bt[n][k], At[m][k], acc[ai][bj][m][n], 0, 0, 0); __builtin_amdgcn_s_setprio(0); } while (0)
#define PG8_WAIT_V(n) asm volatile("s_waitcnt vmcnt(" #n ")" ::: "memory")
#define PG8_WAIT_L(n) asm volatile("s_waitcnt lgkmcnt(" #n ")" ::: "memory")
#define PG8_BAR __builtin_amdgcn_s_barrier()
#define PG8_SCHED __builtin_amdgcn_sched_barrier(0)
    Unit cur, nxt; int ui = 0;
    if (!S.next(0, cur)) return;
    f32x4 acc[2][2][4][2];
#pragma unroll
    for (int a = 0; a < 2; ++a)
#pragma unroll
        for (int b = 0; b < 2; ++b)
#pragma unroll
            for (int m = 0; m < 4; ++m)
#pragma unroll
                for (int n = 0; n < 2; ++n) acc[a][b][m][n] = (f32x4){0.f, 0.f, 0.f, 0.f};
    bf16x8 At[4][2], B0[2][2], B1[2][2];
    const char* cA = (const char*)g.A + (size_t)cur.pm * tstep + (size_t)cur.k0 * kstep; const char* cB = (const char*)g.Bt + (size_t)cur.pn * tstep + (size_t)cur.k0 * kstep;
    S.a_ready(cur);
    if constexpr (SP2) {
        PG8_STAGE(PG8_SB(0, 0), cB, voffB); PG8_STAGE(PG8_SB(0, 1), cB + hstep, voffB); PG8_STAGE(PG8_SA(0, 0), cA, voffA); PG8_STAGE(PG8_SA(0, 1), cA + hstep, voffA);
        if (wr == 1) PG8_BAR;
        PG8_WAIT_V(2); PG8_BAR;
        PG8_STAGE(PG8_SB(1, 0), cB + kstep, voffB); PG8_STAGE(PG8_SA(1, 0), cA + kstep, voffA); PG8_STAGE(PG8_SB(1, 1), cB + hstep + kstep, voffB);
        PG8_WAIT_V(6); PG8_BAR;
    } else {
        PG8_STAGE(PG8_SB(0, 0), cB, voffB); PG8_STAGE(PG8_SA(0, 0), cA, voffA); PG8_STAGE(PG8_SB(0, 1), cB + hstep, voffB); PG8_STAGE(PG8_SA(0, 1), cA + hstep, voffA);
        if (wr == 1) PG8_BAR;
        PG8_WAIT_V(4); PG8_BAR;
        PG8_STAGE(PG8_SB(1, 0), cB + kstep, voffB); PG8_STAGE(PG8_SA(1, 0), cA + kstep, voffA); PG8_STAGE(PG8_SB(1, 1), cB + hstep + kstep, voffB);
        PG8_WAIT_V(6); PG8_BAR;
    }
    for (;;) {
        const bool has_next = S.next(ui + 1, nxt);
        const char* nA = has_next ? (const char*)g.A + (size_t)nxt.pm * tstep + (size_t)nxt.k0 * kstep : cA; const char* nB = has_next ? (const char*)g.Bt + (size_t)nxt.pn * tstep + (size_t)nxt.k0 * kstep : cB;
        const int nt = cur.nk;
        for (int t = 0; t < nt; t += 2) {
            const bool last = (t == nt - 2);
            const char* a1 = cA + (size_t)(t + 1) * kstep;
            const char* a2 = last ? nA : cA + (size_t)(t + 2) * kstep; const char* b2 = last ? nB : cB + (size_t)(t + 2) * kstep;
            const char* a3 = a2 + kstep; const char* b3 = b2 + kstep;
            if (last && has_next) S.a_ready(nxt);
            if constexpr (SP2) {
            PG8_LDB(B0, 0, 0); PG8_LDB(B1, 0, 1); PG8_SCHED; PG8_LDA(At, 0, 0); PG8_STAGE(PG8_SA(1, 1), a1 + hstep, voffA);
            PG8_WAIT_V(8); PG8_WAIT_L(0); PG8_BAR; PG8_MMA(0, 0, At, B0); PG8_MMA(0, 1, At, B1); PG8_BAR; PG8_SCHED;
            PG8_LDA(At, 0, 1); PG8_STAGE(PG8_SB(0, 0), b2, voffB); PG8_STAGE(PG8_SB(0, 1), b2 + hstep, voffB); PG8_STAGE(PG8_SA(0, 0), a2, voffA);
            PG8_WAIT_V(8); PG8_WAIT_L(0); PG8_BAR; PG8_MMA(1, 0, At, B0); PG8_MMA(1, 1, At, B1); PG8_BAR; PG8_SCHED;
            PG8_LDB(B0, 1, 0); PG8_LDB(B1, 1, 1); PG8_SCHED; PG8_LDA(At, 1, 0); PG8_STAGE(PG8_SA(0, 1), a2 + hstep, voffA);
            PG8_WAIT_V(8); PG8_WAIT_L(0); PG8_BAR; PG8_MMA(0, 0, At, B0); PG8_MMA(0, 1, At, B1); PG8_BAR; PG8_SCHED;
            PG8_LDA(At, 1, 1); PG8_STAGE(PG8_SB(1, 0), b3, voffB); PG8_STAGE(PG8_SB(1, 1), b3 + hstep, voffB); PG8_STAGE(PG8_SA(1, 0), a3, voffA);
            PG8_WAIT_V(8); PG8_WAIT_L(0); PG8_BAR; PG8_MMA(1, 0, At, B0); PG8_MMA(1, 1, At, B1); PG8_BAR; PG8_SCHED;
            } else {
            PG8_LDB(B0, 0, 0); PG8_SCHED; PG8_LDA(At, 0, 0); PG8_STAGE(PG8_SA(1, 1), a1 + hstep, voffA);
            PG8_WAIT_L(8); PG8_BAR; PG8_WAIT_L(0); PG8_MMA(0, 0, At, B0); PG8_BAR; PG8_SCHED;
            PG8_LDB(B1, 0, 1); PG8_STAGE(PG8_SB(0, 0), b2, voffB);
            PG8_BAR; PG8_WAIT_L(0); PG8_MMA(0, 1, At, B1); PG8_BAR;
            PG8_LDA(At, 0, 1); PG8_STAGE(PG8_SA(0, 0), a2, voffA);
            PG8_BAR; PG8_WAIT_L(0); PG8_MMA(1, 0, At, B0); PG8_BAR; PG8_SCHED;
            PG8_STAGE(PG8_SB(0, 1), b2 + hstep, voffB);
            PG8_WAIT_V(6); PG8_BAR; PG8_MMA(1, 1, At, B1); PG8_BAR;
            PG8_LDB(B0, 1, 0); PG8_SCHED; PG8_LDA(At, 1, 0); PG8_STAGE(PG8_SA(0, 1), a2 + hstep, voffA);
            PG8_WAIT_L(8); PG8_BAR; PG8_WAIT_L(0); PG8_MMA(0, 0, At, B0); PG8_BAR; PG8_SCHED;
            PG8_LDB(B1, 1, 1); PG8_STAGE(PG8_SB(1, 0), b3, voffB);
            PG8_BAR; PG8_WAIT_L(0); PG8_MMA(0, 1, At, B1); PG8_BAR;
            PG8_LDA(At, 1, 1); PG8_STAGE(PG8_SA(1, 0), a3, voffA);
            PG8_BAR; PG8_WAIT_L(0); PG8_MMA(1, 0, At, B0); PG8_BAR; PG8_SCHED;
            PG8_STAGE(PG8_SB(1, 1), b3 + hstep, voffB);
            PG8_WAIT_V(6); PG8_BAR; PG8_MMA(1, 1, At, B1); PG8_BAR;
            }
        }
        if constexpr (ALIGN_EPI) { if (wr == 0) PG8_BAR; }
        if constexpr (!Epi::AFTER_DRAIN) { E(acc, cur, wr, wc, fr, fq); S.done(cur); }
        if (!has_next) break;
#pragma unroll
        for (int a = 0; a < 2; ++a)
#pragma unroll
            for (int b = 0; b < 2; ++b)
#pragma unroll
                for (int m = 0; m < 4; ++m)
#pragma unroll
                    for (int n = 0; n < 2; ++n) acc[a][b][m][n] = (f32x4){0.f, 0.f, 0.f, 0.f};
        cur = nxt; cA = nA; cB = nB; ++ui;
        if constexpr (ALIGN_EPI) { if (wr == 1) PG8_BAR; }
    }
    PG8_WAIT_V(0);
    if constexpr (!ALIGN_EPI) { if (wr == 0) PG8_BAR; }
    PG8_BAR;
    if constexpr (Epi::AFTER_DRAIN) { E.fused(acc, cur, wr, wc, fr, fq, lds, wid, lane); S.done(cur); }
#undef PG8_SA
#undef PG8_SB
#undef PG8_STAGE
#undef PG8_LDA
#undef PG8_LDB
#undef PG8_MMA
#undef PG8_WAIT_V
#undef PG8_WAIT_L
#undef PG8_BAR
#undef PG8_SCHED
}
}

constexpr int D = 1024, NBATCH = 4, SEQ = 4096, ML = NBATCH * SEQ, CTXL = 256, MC = NBATCH * CTXL, MT = ML + MC, FF = 2816, NFF = 2 * FF, PW = 1280, NMODV = 9 * D;
constexpr int NWAVES = 8;
constexpr float C2 = 0.125f * 1.4426950408889634f;
typedef unsigned short bf16;
typedef unsigned v4u __attribute__((ext_vector_type(4)));
typedef unsigned v2u __attribute__((ext_vector_type(2)));
typedef float f32x4 __attribute__((ext_vector_type(4)));
typedef float f32x16 __attribute__((ext_vector_type(16)));
typedef short bf16x8 __attribute__((ext_vector_type(8)));
typedef short s16x4 __attribute__((ext_vector_type(4)));
#define LAS __attribute__((address_space(3)))
#define LDS_WAIT() asm volatile("s_waitcnt lgkmcnt(0)" ::: "memory")
constexpr size_t MiB = 1u << 20;
constexpr size_t WS_MODS = 0;
constexpr size_t WS_ROPE = 384 * 1024;
constexpr size_t WS_BAR = 448 * 1024;
constexpr size_t WS_W = 1 * MiB;
constexpr size_t W_F1IN = 0, W_F1OUT = W_F1IN + (size_t)NFF * D * 2, W_IN = W_F1OUT + (size_t)D * FF * 2, W_OUT = W_IN + (size_t)PW * D * 2, W_F2IN = W_OUT + (size_t)D * D * 2,
                 W_F2OUT = W_F2IN + (size_t)NFF * D * 2, LW_BYTES = W_F2OUT + (size_t)D * FF * 2;
constexpr size_t WS_H = WS_W + 2 * LW_BYTES;
constexpr size_t WS_XN = WS_H + (size_t)MT * D * 4;
constexpr size_t WS_ACT = WS_XN + (size_t)MT * D * 2;
constexpr size_t WS_END = WS_ACT + (size_t)MT * FF * 2;
static_assert(WS_W + 2 * LW_BYTES == 76 * MiB, "weights");

__device__ __forceinline__ unsigned f2bf(float f) { unsigned u = __builtin_bit_cast(unsigned, f); return (u + 0x7fffu + ((u >> 16) & 1u)) >> 16; }
__device__ __forceinline__ unsigned pk2(float lo, float hi) { return f2bf(lo) | (f2bf(hi) << 16); }
__device__ __forceinline__ float bf_lo(unsigned w) { return __builtin_bit_cast(float, w << 16); }
__device__ __forceinline__ float bf_hi(unsigned w) { return __builtin_bit_cast(float, w & 0xffff0000u); }
__device__ __forceinline__ float wave_sum(float v) {
#pragma unroll
    for (int o = 1; o < 64; o <<= 1) v += __shfl_xor(v, o);
    return v;
}
struct Frame { LAS unsigned char* lds; int tid, lane, wave, G, bid; };

__device__ __forceinline__ int src_swiglu(int n) { return ((n & 255) >> 7) * FF + (n >> 8) * 128 + (n & 127); }
__device__ __forceinline__ int src_qkv(int n) { const int pn = n >> 8, bj = (n >> 7) & 1, wc = (n >> 5) & 3, i = n & 31;
    if (pn < 2) return n; if (pn < 4 || wc < 2) return pn * 256 + wc * 64 + bj * 32 + i; return 1152 + bj * 64 + (wc - 2) * 32 + i; }
__device__ __forceinline__ void transpose_item(const float* W, int N, bf16* WT, int ldk, int kofs, int srcc0, int n0, int k0, LAS float* scr, int lane) {
#pragma unroll 8
    for (int i = 0; i < 32; ++i) { const int kk = 2 * i + (lane >> 5); scr[kk * 33 + (lane & 31)] = __builtin_nontemporal_load(W + (size_t)(k0 + kk) * N + srcc0 + (lane & 31)); }
    LDS_WAIT(); asm volatile("" ::: "memory");
    const int c = lane & 7;
#pragma unroll
    for (int j = 0; j < 4; ++j) { const int n = (lane >> 3) + 8 * j; const LAS float* s = scr + (8 * c) * 33 + n;
        v4u o; o.x = pk2(s[0 * 33], s[1 * 33]); o.y = pk2(s[2 * 33], s[3 * 33]); o.z = pk2(s[4 * 33], s[5 * 33]); o.w = pk2(s[6 * 33], s[7 * 33]);
        *(v4u*)(WT + (size_t)(n0 + n) * ldk + kofs + k0 + 8 * c) = o; }
    LDS_WAIT(); asm volatile("" ::: "memory");
}
__device__ __forceinline__ void fold_item(const float* wpool, const float* pscale, const float* wout, bf16* WoT, int g, int n0, LAS float* scr, int lane) {
#pragma unroll
    for (int i = 0; i < 4; ++i) { const int e = lane + 64 * i;
        const int d = e >> 1, h = e & 1; f32x4 v = *(const f32x4*)(wout + (size_t)(g * 128 + d) * D + n0 + 4 * h); v = v * pscale[g * 128 + d]; *(LAS f32x4*)(scr + d * 8 + 4 * h) = v; }
    LDS_WAIT(); asm volatile("" ::: "memory");
#pragma unroll 1
    for (int cc = 0; cc < 2; ++cc) { const int c = lane + 64 * cc; const float* wp = wpool + ((size_t)g * 128 + c) * 128;
        float acc[8];
#pragma unroll
        for (int n = 0; n < 8; ++n) acc[n] = 0.f;
#pragma unroll 2
        for (int d4 = 0; d4 < 32; ++d4) { const f32x4 w = *(const f32x4*)(wp + 4 * d4);
#pragma unroll
            for (int dd = 0; dd < 4; ++dd) { const f32x4 a = *(const LAS f32x4*)(scr + (4 * d4 + dd) * 8), b = *(const LAS f32x4*)(scr + (4 * d4 + dd) * 8 + 4);
                acc[0] += w[dd] * a[0]; acc[1] += w[dd] * a[1]; acc[2] += w[dd] * a[2]; acc[3] += w[dd] * a[3]; acc[4] += w[dd] * b[0]; acc[5] += w[dd] * b[1]; acc[6] += w[dd] * b[2]; acc[7] += w[dd] * b[3]; } }
#pragma unroll
        for (int n = 0; n < 8; ++n) WoT[(size_t)(n0 + n) * D + g * 128 + c] = (bf16)f2bf(acc[n]); }
    LDS_WAIT(); asm volatile("" ::: "memory");
}
struct In { const float *x, *c, *ctx, *c_ctx, *w_mod, *b_mod, *norm_ffn1, *w_ffn1_in, *w_ffn1_out, *norm_mix, *w_in, *w_pool, *pool_scale, *sink, *w_out, *norm_ffn2, *w_ffn2_in, *w_ffn2_out, *norm_final; };

__device__ __forceinline__ void prologue(const Frame& F, const In& I, unsigned char* ws) {
    float* mods = (float*)(ws + WS_MODS);
    {
        LAS float* sl = (LAS float*)F.lds;
        LAS float* red = (LAS float*)(F.lds + 20480);
        bool have = false;
        for (int it = F.bid; it < 72; it += F.G) {
            if (!have) { for (int e = F.tid; e < 5 * D; e += 512) { const float v = (e < 4 * D) ? I.c[e] : I.c_ctx[e - 4 * D]; sl[e] = v / (1.0f + __expf(-v)); } have = true; __syncthreads(); }
            const int l = it / 36, cgp = it % 36; const float* W = I.w_mod + (size_t)l * D * NMODV + cgp * 256 + 4 * F.lane;
            f32x4 acc[5];
#pragma unroll
            for (int b = 0; b < 5; ++b) acc[b] = (f32x4){0.f, 0.f, 0.f, 0.f};
            const int kb = F.wave * 128;
#pragma unroll 8
            for (int k = 0; k < 128; ++k) { const f32x4 w = __builtin_nontemporal_load((const f32x4*)(W + (size_t)(kb + k) * NMODV));
#pragma unroll
                for (int b = 0; b < 5; ++b) acc[b] += w * sl[b * D + kb + k]; }
#pragma unroll
            for (int b = 0; b < 5; ++b) *(LAS f32x4*)(red + (F.wave * 5 + b) * 256 + 4 * F.lane) = acc[b];
            __syncthreads();
            for (int e = F.tid; e < 5 * 256; e += 512) { const int b = e >> 8, cc = e & 255; float s = I.b_mod[(size_t)l * NMODV + cgp * 256 + cc];
#pragma unroll
                for (int w = 0; w < 8; ++w) s += red[(w * 5 + b) * 256 + cc];
                mods[((size_t)l * 5 + b) * NMODV + cgp * 256 + cc] = s; }
            __syncthreads();
        }
        __syncthreads();
    }
    LAS float* scr = (LAS float*)(F.lds + F.wave * 16384);
    const int gw = F.bid * NWAVES + F.wave, NGW = F.G * NWAVES;
    constexpr int I_FIN = (D / 64) * (NFF / 32), I_FOUT = (FF / 64) * (D / 32), I_IN = (D / 64) * (PW / 32), I_OUT = (512 / 64) * (D / 32), I_FOLD = 4 * (D / 8);
    constexpr int PER_L = 2 * I_FIN + 2 * I_FOUT + I_IN + I_OUT + I_FOLD, NITEMS = 2 * PER_L + 1;
    for (int it = gw; it < NITEMS; it += NGW) {
        if (it == 2 * PER_L) {
            float* rc = (float*)(ws + WS_ROPE); float* rs = rc + 1024;
            for (int f = 0; f < 16; ++f) { const float inv = powf(10000.0f, -(float)(2 * f) / 32.0f); const float a = (float)F.lane * inv; float s, c; sincosf(a, &s, &c); rc[F.lane * 16 + f] = c; rs[F.lane * 16 + f] = s; }
            continue;
        }
        const int l = it / PER_L; int r = it % PER_L; unsigned char* wl = ws + WS_W + (size_t)l * LW_BYTES;
        if (r < 2 * I_FIN) { const bool second = r >= I_FIN; if (second) r -= I_FIN; const float* W = (second ? I.w_ffn2_in : I.w_ffn1_in) + (size_t)l * D * NFF;
            const int nblk = NFF / 32, kb = r / nblk, nb = r % nblk; transpose_item(W, NFF, (bf16*)(wl + (second ? W_F2IN : W_F1IN)), D, 0, src_swiglu(32 * nb), 32 * nb, 64 * kb, scr, F.lane); continue; }
        r -= 2 * I_FIN;
        if (r < 2 * I_FOUT) { const bool second = r >= I_FOUT; if (second) r -= I_FOUT; const float* W = (second ? I.w_ffn2_out : I.w_ffn1_out) + (size_t)l * FF * D;
            const int nblk = D / 32, kb = r / nblk, nb = r % nblk; transpose_item(W, D, (bf16*)(wl + (second ? W_F2OUT : W_F1OUT)), FF, 0, 32 * nb, 32 * nb, 64 * kb, scr, F.lane); continue; }
        r -= 2 * I_FOUT;
        if (r < I_IN) { const float* W = I.w_in + (size_t)l * D * PW; const int nblk = PW / 32, kb = r / nblk, nb = r % nblk;
            transpose_item(W, PW, (bf16*)(wl + W_IN), D, 0, src_qkv(32 * nb), 32 * nb, 64 * kb, scr, F.lane); continue; }
        r -= I_IN;
        if (r < I_OUT) { const float* W = I.w_out + (size_t)l * D * D + (size_t)512 * D; const int nblk = D / 32, kb = r / nblk, nb = r % nblk;
            transpose_item(W, D, (bf16*)(wl + W_OUT), D, 512, 32 * nb, 32 * nb, 64 * kb, scr, F.lane); continue; }
        r -= I_OUT;
        { const int g = r / (D / 8), nb = r % (D / 8);
          fold_item(I.w_pool + (size_t)l * 4 * 128 * 128, I.pool_scale + (size_t)l * 512, I.w_out + (size_t)l * D * D, (bf16*)(wl + W_OUT), g, 8 * nb, scr, F.lane); }
    }
    { bf16* Hc = (bf16*)(ws + WS_H) + (size_t)ML * D; const int n4 = MC * D / 4;
      for (int e = F.bid * 512 + F.tid; e < n4; e += F.G * 512) { const f32x4 v = ((const f32x4*)I.ctx)[e]; v2u w; w.x = pk2(v.x, v.y); w.y = pk2(v.z, v.w); ((v2u*)Hc)[e] = w; } }
}

__device__ __forceinline__ void ld_row(const float* latf, const bf16* Hb, int m, int lane, f32x4 (&v)[4]) {
    if (latf != nullptr && m < ML) {
#pragma unroll
        for (int j = 0; j < 4; ++j) v[j] = *(const f32x4*)(latf + (size_t)m * D + 4 * lane + 256 * j);
    } else {
#pragma unroll
        for (int j = 0; j < 4; ++j) { const v2u w = *(const v2u*)(Hb + (size_t)m * D + 4 * lane + 256 * j); v[j] = (f32x4){bf_lo(w.x), bf_hi(w.x), bf_lo(w.y), bf_hi(w.y)}; } }
}
__device__ __forceinline__ void norm_phase(const Frame& F, const float* latf, bf16* Hb, bf16* XN, const float* g, const float* shift, const float* scale, int nrows, const bf16* slab, int nsplit) {
    const int gw = F.bid * NWAVES + F.wave, NGW = F.G * NWAVES; const int rpw = (ML + NGW - 1) / NGW;
    int m0 = gw * rpw, m1 = m0 + rpw; if (m1 > ML) m1 = ML; if (m0 > ML) m0 = ML;
    const int nctx = nrows - ML;
    int cur_b = -1; f32x4 gs[4], sh[4];
    for (int it = m0; it < m1 + 1; ++it) {
        int m = it;
        if (it == m1) { bool any = false; for (int r = gw; r < nctx; r += NGW) any = true; if (!any) break; m = ML + gw; }
        for (;; ) {
            const int b = m < ML ? (m >> 12) : 4;
            if (b != cur_b) { cur_b = b;
#pragma unroll
                for (int j = 0; j < 4; ++j) { const int col = 4 * F.lane + 256 * j; const f32x4 gv = *(const f32x4*)(g + col), sc = *(const f32x4*)(scale + (size_t)b * NMODV + col); gs[j] = gv * (sc + 1.0f); sh[j] = *(const f32x4*)(shift + (size_t)b * NMODV + col); } }
            f32x4 v[4]; float s = 0.f;
            ld_row(latf, Hb, m, F.lane, v);
            if (m >= ML && nsplit > 0) {
                const bf16* sp = slab + (size_t)(m - ML) * D + 4 * F.lane;
#pragma unroll 4
                for (int q = 0; q < nsplit; ++q) {
#pragma unroll
                    for (int j = 0; j < 4; ++j) { const v2u w = *(const v2u*)(sp + (size_t)q * (MC * D) + 256 * j); v[j] += (f32x4){bf_lo(w.x), bf_hi(w.x), bf_lo(w.y), bf_hi(w.y)}; } }
#pragma unroll
                for (int j = 0; j < 4; ++j) { v2u w; w.x = pk2(v[j].x, v[j].y); w.y = pk2(v[j].z, v[j].w); *(v2u*)(Hb + (size_t)m * D + 4 * F.lane + 256 * j) = w; }
            }
#pragma unroll
            for (int j = 0; j < 4; ++j) s += (v[j].x * v[j].x + v[j].y * v[j].y) + (v[j].z * v[j].z + v[j].w * v[j].w);
            const float rstd = 1.0f / sqrtf(wave_sum(s) * (1.0f / D) + 1e-6f);
            bf16* orow = XN + (size_t)m * D;
#pragma unroll
            for (int j = 0; j < 4; ++j) { const f32x4 o = v[j] * rstd * gs[j] + sh[j]; v2u w; w.x = pk2(o.x, o.y); w.y = pk2(o.z, o.w); *(v2u*)(orow + 4 * F.lane + 256 * j) = w; }
            if (m < ML) break;
            m += NGW; if (m >= ML + nctx) break;
        }
    }
}
__device__ __forceinline__ void final_norm(const Frame& F, const bf16* Hb, float* out, const float* g) {
    const int gw = F.bid * NWAVES + F.wave, NGW = F.G * NWAVES;
    f32x4 gv[4];
#pragma unroll
    for (int j = 0; j < 4; ++j) gv[j] = *(const f32x4*)(g + 4 * F.lane + 256 * j);
    for (int m = gw; m < ML; m += NGW) { f32x4 v[4]; float s = 0.f; ld_row(nullptr, Hb, m, F.lane, v);
#pragma unroll
        for (int j = 0; j < 4; ++j) s += (v[j].x * v[j].x + v[j].y * v[j].y) + (v[j].z * v[j].z + v[j].w * v[j].w);
        const float rstd = 1.0f / sqrtf(wave_sum(s) * (1.0f / D) + 1e-6f);
#pragma unroll
        for (int j = 0; j < 4; ++j) *(f32x4*)(out + (size_t)m * D + 4 * F.lane + 256 * j) = v[j] * rstd * gv[j]; }
}

constexpr int KROWB = 144;
constexpr int KBUF = 64 * KROWB;
__device__ __forceinline__ int crow(int r, int hi) { return (r & 3) + 8 * (r >> 2) + 4 * hi; }
__device__ __forceinline__ void attn_unit(const Frame& F, const bf16* QKV, bf16* MIX, const float* sink, int b, int kvh, int qt, bool isctx) {
    const int lane = F.lane, wid = F.wave, r32 = lane & 31, hi = lane >> 5, tid = F.tid;
    const int head = kvh * 4 + (wid >> 1), qh = wid & 1;
    const int qrow0 = isctx ? (ML + b * CTXL + qt * 64) : (b * SEQ + qt * 64);
    int lo = 0, nloc = 0;
    if (!isctx) { lo = qt - 2 < 0 ? 0 : qt - 2; const int hi_t = qt + 2 > 63 ? 63 : qt + 2; nloc = hi_t - lo + 1; }
    const int ntile = nloc + 4;
    bf16x8 qr[4];
    { const bf16* qp = QKV + (size_t)(qrow0 + 32 * qh + r32) * PW + 512 + head * 64 + hi * 8;
#pragma unroll
      for (int d0 = 0; d0 < 4; ++d0) qr[d0] = *(const bf16x8*)(qp + d0 * 16); }
    const int krow = tid >> 3, kch = tid & 7;
#define TILE_ROW(j) (((j) < nloc) ? (b * SEQ + (lo + (j)) * 64) : (ML + b * CTXL + ((j) - nloc) * 64))
#define LDK(j) (*(const v4u*)(QKV + (size_t)(TILE_ROW(j) + krow) * PW + 1024 + kvh * 64 + kch * 8))
#define LDV(j) (*(const v4u*)(QKV + (size_t)(TILE_ROW(j) + lane) * PW + 1152 + kvh * 64 + wid * 8))
    v4u kA = LDK(0), vA = LDV(0), kB = LDK(1), vB = LDV(1);
    float m_run = sink[head] * 1.4426950408889634f, l_run = (hi == 0) ? 1.0f : 0.0f;
    f32x16 o0 = {}, o1 = {};
    const int qpos = qt * 64 + 32 * qh + r32;
    auto stage = [&](int slot, const v4u& kreg, const v4u& vreg) __attribute__((always_inline)) {
        LAS unsigned char* kb = F.lds + slot * (2 * KBUF); LAS unsigned char* vb = kb + KBUF;
        *(LAS v4u*)(kb + krow * KROWB + kch * 16) = kreg;
        { LAS unsigned short* vt = (LAS unsigned short*)(vb + (wid * 8) * KROWB + lane * 2);
          vt[0 * (KROWB / 2)] = (unsigned short)(vreg.x & 0xffff); vt[1 * (KROWB / 2)] = (unsigned short)(vreg.x >> 16); vt[2 * (KROWB / 2)] = (unsigned short)(vreg.y & 0xffff); vt[3 * (KROWB / 2)] = (unsigned short)(vreg.y >> 16);
          vt[4 * (KROWB / 2)] = (unsigned short)(vreg.z & 0xffff); vt[5 * (KROWB / 2)] = (unsigned short)(vreg.z >> 16); vt[6 * (KROWB / 2)] = (unsigned short)(vreg.w & 0xffff); vt[7 * (KROWB / 2)] = (unsigned short)(vreg.w >> 16); }
    };
    auto compute = [&](int j, int slot) __attribute__((always_inline)) {
        LAS unsigned char* kb = F.lds + slot * (2 * KBUF); LAS unsigned char* vb = kb + KBUF;
        f32x16 p0 = {}, p1 = {};
#pragma unroll
        for (int d0 = 0; d0 < 4; ++d0) { const bf16x8 k0 = *(const LAS bf16x8*)(kb + r32 * KROWB + d0 * 32 + hi * 16), k1 = *(const LAS bf16x8*)(kb + (32 + r32) * KROWB + d0 * 32 + hi * 16);
            p0 = __builtin_amdgcn_mfma_f32_32x32x16_bf16(k0, qr[d0], p0, 0, 0, 0); p1 = __builtin_amdgcn_mfma_f32_32x32x16_bf16(k1, qr[d0], p1, 0, 0, 0); }
        if (j < nloc) { const int kbase = (lo + j) * 64 - qpos;
            const int dt = lo + j - qt;
            if (dt == -2 || dt == 2) {
#pragma unroll
                for (int r = 0; r < 16; ++r) { const int d0 = kbase + crow(r, hi), d1 = d0 + 32; if (d0 > 128 || d0 < -128) p0[r] = -1e30f; if (d1 > 128 || d1 < -128) p1[r] = -1e30f; } } }
        float mx = p0[0];
#pragma unroll
        for (int r = 1; r < 16; ++r) mx = fmaxf(mx, p0[r]);
#pragma unroll
        for (int r = 0; r < 16; ++r) mx = fmaxf(mx, p1[r]);
        mx = fmaxf(mx, __shfl_xor(mx, 32));
        const float mn = fmaxf(m_run, mx), alpha = __builtin_amdgcn_exp2f(m_run - mn); m_run = mn;
        float ps = 0.f;
#pragma unroll
        for (int r = 0; r < 16; ++r) { p0[r] = __builtin_amdgcn_exp2f(p0[r] - mn); p1[r] = __builtin_amdgcn_exp2f(p1[r] - mn); ps += p0[r] + p1[r]; }
        l_run = l_run * alpha + ps;
#pragma unroll
        for (int r = 0; r < 16; ++r) { o0[r] *= alpha; o1[r] *= alpha; }
#pragma unroll
        for (int c = 0; c < 4; ++c) {
            v4u pw;
            if (c == 0) { pw.x = pg8::cvt_pk_bf16(p0[0], p0[1]); pw.y = pg8::cvt_pk_bf16(p0[2], p0[3]); pw.z = pg8::cvt_pk_bf16(p0[4], p0[5]); pw.w = pg8::cvt_pk_bf16(p0[6], p0[7]); }
            else if (c == 1) { pw.x = pg8::cvt_pk_bf16(p0[8], p0[9]); pw.y = pg8::cvt_pk_bf16(p0[10], p0[11]); pw.z = pg8::cvt_pk_bf16(p0[12], p0[13]); pw.w = pg8::cvt_pk_bf16(p0[14], p0[15]); }
            else if (c == 2) { pw.x = pg8::cvt_pk_bf16(p1[0], p1[1]); pw.y = pg8::cvt_pk_bf16(p1[2], p1[3]); pw.z = pg8::cvt_pk_bf16(p1[4], p1[5]); pw.w = pg8::cvt_pk_bf16(p1[6], p1[7]); }
            else { pw.x = pg8::cvt_pk_bf16(p1[8], p1[9]); pw.y = pg8::cvt_pk_bf16(p1[10], p1[11]); pw.z = pg8::cvt_pk_bf16(p1[12], p1[13]); pw.w = pg8::cvt_pk_bf16(p1[14], p1[15]); }
            const bf16x8 pf = __builtin_bit_cast(bf16x8, pw);
#pragma unroll
            for (int dh = 0; dh < 2; ++dh) { const LAS unsigned char* vp = vb + (dh * 32 + r32) * KROWB + (16 * c + 4 * hi) * 2;
                const s16x4 a = *(const LAS s16x4*)vp, bq = *(const LAS s16x4*)(vp + 16);
                const bf16x8 vf = (bf16x8){a[0], a[1], a[2], a[3], bq[0], bq[1], bq[2], bq[3]};
                if (dh == 0) o0 = __builtin_amdgcn_mfma_f32_32x32x16_bf16(vf, pf, o0, 0, 0, 0); else o1 = __builtin_amdgcn_mfma_f32_32x32x16_bf16(vf, pf, o1, 0, 0, 0); }
        }
    };
    for (int j = 0, par = 0; j < ntile; j += 2, par ^= 2) {
        stage(par, kA, vA); if (j + 1 < ntile) stage(par + 1, kB, vB);
        asm volatile("s_waitcnt lgkmcnt(0)" ::: "memory"); __builtin_amdgcn_s_barrier(); asm volatile("" ::: "memory");
        if (j + 2 < ntile) { kA = LDK(j + 2); vA = LDV(j + 2); }
        if (j + 3 < ntile) { kB = LDK(j + 3); vB = LDV(j + 3); }
        compute(j, par); if (j + 1 < ntile) compute(j + 1, par + 1);
    }
#undef TILE_ROW
#undef LDK
#undef LDV
    const float lt = l_run + __shfl_xor(l_run, 32), inv = 1.0f / lt;
    bf16* op = MIX + (size_t)(qrow0 + 32 * qh + r32) * D + 512 + head * 64;
#pragma unroll
    for (int rq = 0; rq < 4; ++rq) { const int d = 8 * rq + 4 * hi;
        v2u w; w.x = pg8::cvt_pk_bf16(o0[4 * rq] * inv, o0[4 * rq + 1] * inv); w.y = pg8::cvt_pk_bf16(o0[4 * rq + 2] * inv, o0[4 * rq + 3] * inv); *(v2u*)(op + d) = w;
        w.x = pg8::cvt_pk_bf16(o1[4 * rq] * inv, o1[4 * rq + 1] * inv); w.y = pg8::cvt_pk_bf16(o1[4 * rq + 2] * inv, o1[4 * rq + 3] * inv); *(v2u*)(op + 32 + d) = w; }
    asm volatile("s_waitcnt lgkmcnt(0)" ::: "memory"); __builtin_amdgcn_s_barrier(); asm volatile("" ::: "memory");
}
template <int W> __device__ __forceinline__ void pool_seg(const bf16* QKV, bf16* MIX, int base, int Tn, int t0, int cc) {
    v4u rr[W + 7];
#pragma unroll
    for (int i = 0; i < W + 7; ++i) { const int tt = t0 - W / 2 + i; rr[i] = (v4u){0u, 0u, 0u, 0u}; if (tt >= 0 && tt < Tn) rr[i] = *(const v4u*)(QKV + (size_t)(base + tt) * PW + cc); }
#pragma unroll
    for (int r = 0; r < 8; ++r) { const int t = t0 + r; int lo = t - W / 2, hi = t + W - W / 2; if (lo < 0) lo = 0; if (hi > Tn) hi = Tn;
        float s[8];
#pragma unroll
        for (int i = 0; i < 8; ++i) s[i] = 0.f;
#pragma unroll
        for (int i = 0; i < W; ++i) { const v4u v = rr[r + i];
            s[0] += bf_lo(v.x); s[1] += bf_hi(v.x); s[2] += bf_lo(v.y); s[3] += bf_hi(v.y); s[4] += bf_lo(v.z); s[5] += bf_hi(v.z); s[6] += bf_lo(v.w); s[7] += bf_hi(v.w); }
        const float inv = 1.0f / (float)(hi - lo); const v4u u = rr[r + W / 2];
        v4u o; o.x = pk2(s[0] * inv - bf_lo(u.x), s[1] * inv - bf_hi(u.x)); o.y = pk2(s[2] * inv - bf_lo(u.y), s[3] * inv - bf_hi(u.y));
        o.z = pk2(s[4] * inv - bf_lo(u.z), s[5] * inv - bf_hi(u.z)); o.w = pk2(s[6] * inv - bf_lo(u.w), s[7] * inv - bf_hi(u.w));
        *(v4u*)(MIX + (size_t)(base + t) * D + cc) = o; }
}
__device__ __forceinline__ void pool_item(const Frame& F, const bf16* QKV, bf16* MIX, int r0) {
    int base, Tn; if (r0 < ML) { base = r0 & ~(SEQ - 1); Tn = SEQ; } else { base = ML + ((r0 - ML) & ~(CTXL - 1)); Tn = CTXL; }
    const int g = F.wave >> 1, cc = (g * 16 + (F.wave & 1) * 8 + (F.lane & 7)) * 8, t0 = (r0 - base) + (F.lane >> 3) * 8;
    if (g == 0) pool_seg<2>(QKV, MIX, base, Tn, t0, cc); else if (g == 1) pool_seg<4>(QKV, MIX, base, Tn, t0, cc); else if (g == 2) pool_seg<8>(QKV, MIX, base, Tn, t0, cc); else pool_seg<16>(QKV, MIX, base, Tn, t0, cc);
}
__device__ __forceinline__ void mixer_phase(const Frame& F, const bf16* QKV, bf16* MIX, const float* sink, bool do_ctx) {
    const int n_lat = NBATCH * 2 * 64, n_ctx = do_ctx ? NBATCH * 2 * 4 : 0, n_pool = (do_ctx ? MT : ML) / 64, total = n_lat + n_ctx + n_pool;
    for (int L = F.bid; L < total; L += F.G) {
        if (L < n_lat) { const int qt = L & 63, kvh = (L >> 6) & 1, b = L >> 7; attn_unit(F, QKV, MIX, sink, b, kvh, qt, false); }
        else if (L < n_lat + n_ctx) { const int u = L - n_lat; const int qt = u & 3, kvh = (u >> 2) & 1, b = u >> 3; attn_unit(F, QKV, MIX, sink, b, kvh, qt, true); }
        else pool_item(F, QKV, MIX, (L - n_lat - n_ctx) * 64);
    }
}

#define XB_TMO      128
#define XB_XCNT(j)  (256  + 64 * (j))
#define XB_XSUB(j)  (1280 + 64 * (j))
#define XB_XGEN(j)  (2304 + 64 * (j))
#define XB_TOP      3328
#define XB_TOPGEN   3392
#define XCD_BAR_WORDS 3456
#define XB_SPIN_CAP (1u << 18)

__device__ __forceinline__ unsigned xb_ld(unsigned* p)              { return __hip_atomic_load(p, __ATOMIC_RELAXED, __HIP_MEMORY_SCOPE_AGENT); }
__device__ __forceinline__ unsigned xb_add(unsigned* p, unsigned v) { return __hip_atomic_fetch_add(p, v, __ATOMIC_RELAXED, __HIP_MEMORY_SCOPE_AGENT); }
__device__ __forceinline__ unsigned xb_xcc_id() { return (unsigned)__builtin_amdgcn_s_getreg((3 << 11) | 20) & 0xFu; }
#define XB_SPIN(cond, bar) do { unsigned _sp = 0; while (cond) { __builtin_amdgcn_s_sleep(1); \
    if ((++_sp & 255u) == 0u) { if (xb_ld(&(bar)[XB_TMO])) break; if (_sp > XB_SPIN_CAP) { atomicAdd(&(bar)[XB_TMO], 1u); break; } } } } while (0)

struct XcdBarrier {
    unsigned* bar; unsigned x;
    volatile LAS unsigned* st;
};

__device__ __forceinline__ XcdBarrier xcd_barrier_post(unsigned* bar, volatile LAS unsigned* st) {
    XcdBarrier b; b.bar = bar; b.x = xb_xcc_id(); b.st = st;
    if (threadIdx.x == 0) (void)xb_add(&bar[XB_XCNT(b.x)], 1u);
    return b;
}
__device__ __forceinline__ void xcd_barrier_complete(unsigned* bar, unsigned x, unsigned& nloc, unsigned& nx) {
    const unsigned G = gridDim.x * gridDim.y * gridDim.z;
    unsigned sum, cnt, mine, sp = 0u;
    for (;;) {
        sum = 0u; cnt = 0u; mine = 0u;
#pragma unroll
        for (unsigned j = 0; j < 16; ++j) { const unsigned c = xb_ld(&bar[XB_XCNT(j)]); sum += c; cnt += (c > 0u) ? 1u : 0u; mine = (j == x) ? c : mine; }
        if (sum == G) break;
        __builtin_amdgcn_s_sleep(1);
        if ((++sp & 255u) == 0u) { if (xb_ld(&bar[XB_TMO])) break; if (sp > XB_SPIN_CAP) { atomicAdd(&bar[XB_TMO], 1u); break; } }
    }
    nloc = mine > 0u ? mine : 1u; nx = cnt > 0u ? cnt : 1u;
}

__device__ __forceinline__ void xcd_barrier(const XcdBarrier& b) {
    asm volatile("s_waitcnt vmcnt(0)" ::: "memory");
    __syncthreads();
    if (threadIdx.x == 0) {
        unsigned* bar = b.bar;
        __builtin_amdgcn_s_waitcnt(0);
        unsigned nloc = b.st[0], nx = b.st[1];
        if (nloc == 0u) { xcd_barrier_complete(bar, b.x, nloc, nx); b.st[0] = nloc; b.st[1] = nx; }
        const unsigned old = xb_add(&bar[XB_XSUB(b.x)], 1u);
        const unsigned gen = old / nloc;
        if (old + 1u == (gen + 1u) * nloc) {
            __builtin_amdgcn_fence(__ATOMIC_RELEASE, "agent");
            asm volatile("s_waitcnt vmcnt(0)" ::: "memory");
            const unsigned og = xb_add(&bar[XB_TOP], 1u);
            const unsigned tg = og / nx;
            if (og + 1u == (tg + 1u) * nx) xb_add(&bar[XB_TOPGEN], 1u);
            else XB_SPIN(xb_ld(&bar[XB_TOPGEN]) == tg, bar);
            __builtin_amdgcn_fence(__ATOMIC_ACQUIRE, "agent");
            xb_add(&bar[XB_XGEN(b.x)], 1u);
            asm volatile("s_waitcnt vmcnt(0)" ::: "memory");
        } else {
            XB_SPIN(xb_ld(&bar[XB_XGEN(b.x)]) == gen, bar);
            __builtin_amdgcn_fence(__ATOMIC_ACQUIRE, "agent");
            asm volatile("s_waitcnt vmcnt(0)" ::: "memory");
        }
    }
    __syncthreads();
}
#ifndef XP
#define XP 0
#endif
#define GSYNC() do { xcd_barrier(xbar); if (XP == 1) xcd_barrier(xbar); } while (0)
#define REPS(x) for (int rep_ = 0; rep_ < ((XP == (x)) ? 2 : 1); ++rep_)
#ifndef PHASES
#define PHASES 0xFFFF
#endif
#define PH(n) if (PHASES & (1 << (n)))
constexpr int LDS_BYTES = 147456;
struct Args { const void* p[21]; };
__device__ __forceinline__ const float* argf(const Args& a, int k) { asm volatile("" : "+s"(k)); return (const float*)a.p[k]; }
__device__ __forceinline__ unsigned char* argws(const Args& a) { int k = 20; asm volatile("" : "+s"(k)); return (unsigned char*)a.p[k]; }
#define MKFRAME() Frame F; F.lds = (LAS unsigned char*)lds; F.tid = threadIdx.x; asm volatile("" : "+v"(F.tid)); F.lane = F.tid & 63; F.wave = __builtin_amdgcn_readfirstlane(F.tid >> 6); F.G = gridDim.x; F.bid = blockIdx.x
__global__ void __launch_bounds__(NWAVES * 64, 2) fwd_megakernel(Args args) {
    extern __shared__ __attribute__((aligned(16))) unsigned char lds[];
    cg::grid_group grid = cg::this_grid();
    volatile LAS unsigned* xst = (volatile LAS unsigned*)((LAS unsigned char*)lds + 131072 + 64);
    if (threadIdx.x < 2) xst[threadIdx.x] = 0u;
    __syncthreads();
    const XcdBarrier xbar = xcd_barrier_post((unsigned*)(argws(args) + WS_BAR), xst);
    REPS(5) PH(0) { MKFRAME();
        In I; I.x = argf(args, 0); I.c = argf(args, 1); I.ctx = argf(args, 2); I.c_ctx = argf(args, 3); I.w_mod = argf(args, 4); I.b_mod = argf(args, 5); I.norm_ffn1 = argf(args, 6); I.w_ffn1_in = argf(args, 7); I.w_ffn1_out = argf(args, 8);
        I.norm_mix = argf(args, 9); I.w_in = argf(args, 10); I.w_pool = argf(args, 11); I.pool_scale = argf(args, 12); I.sink = argf(args, 13); I.w_out = argf(args, 14); I.norm_ffn2 = argf(args, 15); I.w_ffn2_in = argf(args, 16); I.w_ffn2_out = argf(args, 17); I.norm_final = argf(args, 18);
        prologue(F, I, argws(args)); }
    GSYNC();
    if (gridDim.x == 0x7fffffffu) grid.sync();
#pragma unroll 1
    for (int st = 0; st < 20; ++st) {
        const int l = st >= 10 ? 1 : 0, k = st - 10 * l;
        if (k == 0 || k == 3 || k == 7) { REPS(3) PH(1) { MKFRAME(); unsigned char* ws = argws(args); bf16* H = (bf16*)(ws + WS_H);
            const int j = (k == 0) ? 0 : (k == 3 ? 3 : 6); const float* ml = (const float*)(ws + WS_MODS) + (size_t)l * 5 * NMODV + j * D;
            const float* gw = argf(args, k == 0 ? 6 : (k == 3 ? 9 : 15)) + l * D;
            norm_phase(F, (st == 0) ? argf(args, 0) : nullptr, H, (bf16*)(ws + WS_XN), gw, ml, ml + D, (st == 17) ? ML : MT, (const bf16*)argf(args, 19), (st == 0 || st == 17) ? 0 : (k == 7 ? 4 : 11)); } }
        else if (k == 1 || k == 8) { REPS(6) PH(2) { unsigned char* ws = argws(args); unsigned char* wl = ws + WS_W + (size_t)l * LW_BYTES; const int nm = ((st == 18) ? ML : MT) / 256;
            pg8::Gemm g{(const bf16*)(ws + WS_XN), (const bf16*)(wl + (k == 1 ? W_F1IN : W_F2IN)), MT, NFF, D}; pg8::Sched<NFF / 256> S{nm, D / 64, (int)gridDim.x, (int)blockIdx.x, nm * (NFF / 256), 0, 1, 2};
            pg8::EpiSwiglu E{(bf16*)(ws + WS_ACT), FF}; pg8::gemm_phase<pg8::EpiSwiglu, pg8::Sched<NFF / 256>, true, true>((LAS unsigned char*)lds, g, S, E); } }
        else if (k == 2 || k == 6 || k == 9) { REPS(7) PH(3) { unsigned char* ws = argws(args); unsigned char* wl = ws + WS_W + (size_t)l * LW_BYTES; pg8::bf16_t* H = (pg8::bf16_t*)(ws + WS_H);
            const int j = (k == 2) ? 2 : (k == 6 ? 5 : 8); const float* gate = (const float*)(ws + WS_MODS) + (size_t)l * 5 * NMODV + j * D;
            const bool wo = (k == 6); const int nctx = (l == 1 && k != 2) ? 0 : 16; const bool nosplit = (XP == 2);
            pg8::Gemm g{(const bf16*)(ws + (wo ? WS_XN : WS_ACT)), (const bf16*)(wl + (k == 2 ? W_F1OUT : (wo ? W_OUT : W_F2OUT))), MT, D, wo ? D : FF};
            pg8::Sched<D / 256> S{ML / 256, (wo ? D : FF) / 64, (int)gridDim.x, (int)blockIdx.x, (ML / 256) * (D / 256), nosplit ? 0 : nctx, wo ? 4 : 11, 4}; if (nosplit) { S.nM = ML / 256 + nctx / 4; S.nmain = S.nM * 4; }
            pg8::EpiRes E{(st == 2 && rep_ == 0) ? argf(args, 0) : nullptr, H, gate, NMODV, (rep_ == 1) ? 0.0f : (wo ? 1.0f : 0.5f), (pg8::bf16_t*)argf(args, 19)}; pg8::gemm_phase<pg8::EpiRes, pg8::Sched<D / 256>, true, true>((LAS unsigned char*)lds, g, S, E); } }
        else if (k == 4) { REPS(8) PH(5) { unsigned char* ws = argws(args); unsigned char* wl = ws + WS_W + (size_t)l * LW_BYTES; const float* ropeC = (const float*)(ws + WS_ROPE);
            pg8::Gemm g{(const bf16*)(ws + WS_XN), (const bf16*)(wl + W_IN), MT, PW, D}; pg8::Sched<PW / 256> S{MT / 256, D / 64, (int)gridDim.x, (int)blockIdx.x, (MT / 256) * (PW / 256), 0, 1, 2};
            pg8::EpiQKV E{(bf16*)(ws + WS_ACT), ropeC, ropeC + 1024, C2}; pg8::gemm_phase<pg8::EpiQKV, pg8::Sched<PW / 256>, true, true>((LAS unsigned char*)lds, g, S, E); } }
        else { REPS(4) PH(6) { MKFRAME(); unsigned char* ws = argws(args); mixer_phase(F, (const bf16*)(ws + WS_ACT), (bf16*)(ws + WS_XN), argf(args, 13) + l * 8, l == 0); } }
        GSYNC();
    }
    PH(11) { MKFRAME(); unsigned char* ws = argws(args); int k = 19; asm volatile("" : "+s"(k)); final_norm(F, (const bf16*)(ws + WS_H), (float*)args.p[k], argf(args, 18)); }
}

extern "C" void kernel_launch(void* const* d_in, const int* in_sizes, int n_in, void* d_out, int out_size, void* d_ws, size_t ws_size, hipStream_t stream) {
    static int grid_blocks = 0;
    if (grid_blocks == 0) {
        if (n_in != 19 || out_size != ML * D || ws_size < WS_END) { fprintf(stderr, "kernel_launch: unexpected shapes (n_in %d, out %d, ws %zu < %zu)\n", n_in, out_size, ws_size, (size_t)WS_END); grid_blocks = -1; return; }
        int dev = 0, cus = 0, per_cu = 0;
        (void)hipGetDevice(&dev); (void)hipDeviceGetAttribute(&cus, hipDeviceAttributeMultiprocessorCount, dev);
        if (hipFuncSetAttribute((const void*)fwd_megakernel, hipFuncAttributeMaxDynamicSharedMemorySize, LDS_BYTES) != hipSuccess) { fprintf(stderr, "kernel_launch: hipFuncSetAttribute failed\n"); grid_blocks = -1; return; }
        if (hipOccupancyMaxActiveBlocksPerMultiprocessor(&per_cu, (const void*)fwd_megakernel, NWAVES * 64, LDS_BYTES) != hipSuccess || per_cu < 1) { fprintf(stderr, "kernel_launch: occupancy query gave %d\n", per_cu); per_cu = 1; }
        (void)hipGetLastError();
        grid_blocks = cus * per_cu;
    }
    if (grid_blocks < 0) return;
    if (hipMemsetAsync((char*)d_ws + WS_BAR, 0, XCD_BAR_WORDS * 4, stream) != hipSuccess) { fprintf(stderr, "kernel_launch: memset failed\n"); return; }
    Args a{};
    for (int i = 0; i < 19; ++i) a.p[i] = d_in[i];
    a.p[19] = d_out; a.p[20] = d_ws;
    void* kargs[] = {&a};
    hipError_t e = hipLaunchCooperativeKernel((const void*)fwd_megakernel, dim3(grid_blocks), dim3(NWAVES * 64), kargs, LDS_BYTES, stream);
    if (e != hipSuccess) fprintf(stderr, "kernel_launch: cooperative launch failed: %s (grid %d)\n", hipGetErrorString(e), grid_blocks);
}
```

```cpp
#include <hip/hip_runtime.h>
#include <hip/hip_cooperative_groups.h>
#include <cstdio>
#include <cstdint>
namespace cg = cooperative_groups;
namespace pg8 {
#define PG8_LAS __attribute__((address_space(3)))
typedef unsigned short bf16_t;
typedef short bf16x8 __attribute__((ext_vector_type(8)));
typedef float f32x4 __attribute__((ext_vector_type(4)));
typedef unsigned u32x4 __attribute__((ext_vector_type(4)));
constexpr int BM = 256, BK = 64, HALF = 128, HTB = HALF * BK * 2  , STAGE_BYTES = 8 * HTB, NXCD = 8, WGM = 8;

__host__ __device__ __forceinline__ int lds_byte(int r, int c) { const int st = (r >> 4) * 2 + (c >> 5), rr = r & 15, cc = c & 31, ob = rr * 64 + cc * 2; return st * 1024 + (ob ^ (((ob >> 9) & 1) << 5)); }
__host__ __device__ __forceinline__ void stage_rc(int b, int& R, int& C) { const int st = b / 1024, sb = b % 1024, swz = sb ^ (((sb >> 9) & 1) << 5); R = (st >> 1) * 16 + swz / 64; C = (st & 1) * 32 + (swz % 64) / 2; }
__host__ __device__ __forceinline__ int perm32(int rho) { const int n = rho >> 4, i = rho & 15; return 8 * (i >> 2) + 4 * n + (i & 3); }

struct Unit { int pm, pn, k0, nk, fl; };
struct Gemm { const bf16_t* A; const bf16_t* Bt; int M, N, K; };
typedef float f32x2_t __attribute__((ext_vector_type(2))); typedef __bf16 bf16x2_t __attribute__((ext_vector_type(2)));
__device__ __forceinline__ unsigned cvt_pk_bf16(float lo, float hi) { f32x2_t v = {lo, hi}; bf16x2_t b = __builtin_convertvector(v, bf16x2_t); return __builtin_bit_cast(unsigned, b); }
typedef float f32x2 __attribute__((ext_vector_type(2)));

template <int NN> __device__ __forceinline__ void tile_of(int L, int nM, int& pm, int& pn) {
    static_assert(NXCD == 8 && WGM == 8, "shifts below");
    const int nwg = nM * NN; int wgid = L;
    { const int q = nwg >> 3, r = nwg & 7, xcd = wgid & 7, off = wgid >> 3; wgid = (xcd < r ? xcd * (q + 1) : r * (q + 1) + (xcd - r) * q) + off; }
    constexpr int nig = WGM * NN; const int gid = wgid / nig, rem = wgid - gid * nig, fm = gid * WGM, gsz = (nM - fm) < WGM ? (nM - fm) : WGM;
    if (gsz == WGM) { pm = fm + (rem & 7); pn = rem >> 3; } else { pm = fm + rem % gsz; pn = rem / gsz; }
}
template <int NN> struct Sched {
    int nM, nkt, G, c, nmain, nctxu, nsplit, kper;
    __device__ __forceinline__ bool next(int i, Unit& u) const {
        const int L = i * G + c;
        if (L < nmain) { tile_of<NN>(L, nM, u.pm, u.pn); u.k0 = 0; u.nk = nkt; u.fl = 0; return true; }
        const int s = L - nmain; if (s >= nctxu * nsplit) return false;
        const int uu = s / nsplit, ks = s - uu * nsplit; u.pm = nM + uu / NN; u.pn = uu % NN; u.k0 = ks * kper; u.nk = kper; u.fl = 1; return true;
    }
    __device__ __forceinline__ void a_ready(const Unit&) const {}
    __device__ __forceinline__ void done(const Unit&) const {}
};
__device__ __forceinline__ float silu_mul(float a, float b) { const float e = __builtin_amdgcn_exp2f(a * -1.4426950408889634f); return a * b * __builtin_amdgcn_rcpf(1.0f + e); }
struct EpiSwiglu {
    static constexpr bool PERM = true, AFTER_DRAIN = false;
    bf16_t* O; int ldc;
    __device__ __forceinline__ void operator()(const f32x4 (&acc)[2][2][4][2], const Unit& u, int wr, int wc, int fr, int fq) const {
        const int row0 = u.pm * BM + wr * 64 + fr, col0 = u.pn * HALF + wc * 32 + 8 * fq;
#pragma unroll
        for (int ai = 0; ai < 2; ++ai)
#pragma unroll
            for (int m = 0; m < 4; ++m) { bf16_t* rowp = O + (size_t)(row0 + ai * HALF + m * 16) * ldc + col0;
                const f32x4 a0 = acc[ai][0][m][0], a1 = acc[ai][0][m][1], b0 = acc[ai][1][m][0], b1 = acc[ai][1][m][1];
                u32x4 w; w.x = cvt_pk_bf16(silu_mul(a0[0], b0[0]), silu_mul(a0[1], b0[1])); w.y = cvt_pk_bf16(silu_mul(a0[2], b0[2]), silu_mul(a0[3], b0[3]));
                w.z = cvt_pk_bf16(silu_mul(a1[0], b1[0]), silu_mul(a1[1], b1[1])); w.w = cvt_pk_bf16(silu_mul(a1[2], b1[2]), silu_mul(a1[3], b1[3]));
                *(u32x4*)rowp = w; }
    }
};
struct EpiRes {
    static constexpr bool PERM = true, AFTER_DRAIN = false;
    const float* basef; bf16_t* Hb; const float* gate; int gstride; float coef; bf16_t* slab;
    __device__ __forceinline__ void operator()(const f32x4 (&acc)[2][2][4][2], const Unit& u, int wr, int wc, int fr, int fq) const {
        const int bidx = u.pm < 64 ? (u.pm >> 4) : 4; const float* gp = gate + (size_t)bidx * gstride;
        const int col0 = u.pn * BM + wc * 32 + 8 * fq;
        f32x4 gv[2][2];
#pragma unroll
        for (int bj = 0; bj < 2; ++bj)
#pragma unroll
            for (int n = 0; n < 2; ++n) gv[bj][n] = *(const f32x4*)(gp + col0 + bj * HALF + n * 4) * coef;
        const bool f32base = (basef != nullptr) && (u.pm < 64);
#pragma unroll
        for (int ai = 0; ai < 2; ++ai)
#pragma unroll
            for (int m = 0; m < 4; ++m) { const size_t off = (size_t)(u.pm * BM + ai * HALF + wr * 64 + m * 16 + fr) * 1024 + col0;
#pragma unroll
                for (int bj = 0; bj < 2; ++bj) { const size_t o = off + bj * HALF; const f32x4 v0 = acc[ai][bj][m][0] * gv[bj][0], v1 = acc[ai][bj][m][1] * gv[bj][1];
                    if (u.fl) { u32x4 w; w.x = cvt_pk_bf16(v0[0], v0[1]); w.y = cvt_pk_bf16(v0[2], v0[3]); w.z = cvt_pk_bf16(v1[0], v1[1]); w.w = cvt_pk_bf16(v1[2], v1[3]);
                        *(u32x4*)(slab + (size_t)(u.k0 >> 2) * (1024 * 1024) + (o - (size_t)16384 * 1024)) = w; }
                    else { f32x4 b0, b1;
                        if (f32base) { b0 = __builtin_nontemporal_load((const f32x4*)(basef + o)); b1 = __builtin_nontemporal_load((const f32x4*)(basef + o + 4)); }
                        else { const u32x4 w = *(const u32x4*)(Hb + o); b0 = (f32x4){__builtin_bit_cast(float, w.x << 16), __builtin_bit_cast(float, w.x & 0xffff0000u), __builtin_bit_cast(float, w.y << 16), __builtin_bit_cast(float, w.y & 0xffff0000u)};
                            b1 = (f32x4){__builtin_bit_cast(float, w.z << 16), __builtin_bit_cast(float, w.z & 0xffff0000u), __builtin_bit_cast(float, w.w << 16), __builtin_bit_cast(float, w.w & 0xffff0000u)}; }
                        b0 += v0; b1 += v1; u32x4 w; w.x = cvt_pk_bf16(b0[0], b0[1]); w.y = cvt_pk_bf16(b0[2], b0[3]); w.z = cvt_pk_bf16(b1[0], b1[1]); w.w = cvt_pk_bf16(b1[2], b1[3]);
                        *(u32x4*)(Hb + o) = w; } } }
    }
};
struct EpiQKV {
    static constexpr bool PERM = true, AFTER_DRAIN = false;
    bf16_t* O; const float* ropeC; const float* ropeS; float qscale;
    __device__ __forceinline__ void operator()(const f32x4 (&acc)[2][2][4][2], const Unit& u, int wr, int wc, int fr, int fq) const {
        const int row0 = u.pm * BM + wr * 64 + fr; const bool latent = u.pm < 64;
        if (u.pn < 2 || (u.pn == 4 && wc >= 2)) {
#pragma unroll
            for (int bj = 0; bj < 2; ++bj) { const int col = (u.pn < 2) ? (u.pn * BM + bj * HALF + wc * 32 + 8 * fq) : (1152 + bj * 64 + (wc - 2) * 32 + 8 * fq);
#pragma unroll
                for (int ai = 0; ai < 2; ++ai)
#pragma unroll
                    for (int m = 0; m < 4; ++m) { const f32x4 v0 = acc[ai][bj][m][0], v1 = acc[ai][bj][m][1];
                        u32x4 w; w.x = cvt_pk_bf16(v0[0], v0[1]); w.y = cvt_pk_bf16(v0[2], v0[3]); w.z = cvt_pk_bf16(v1[0], v1[1]); w.w = cvt_pk_bf16(v1[2], v1[3]);
                        *(u32x4*)(O + (size_t)(row0 + ai * HALF + m * 16) * 1280 + col) = w; } }
        } else {
            const int dst1 = u.pn * BM + wc * 64 + 8 * fq; const float sc = (u.pn < 4) ? qscale : 1.0f; const int fb = 8 * (fq & 1);
#pragma unroll
            for (int ai = 0; ai < 2; ++ai)
#pragma unroll
                for (int m = 0; m < 4; ++m) { const int r = row0 + ai * HALF + m * 16; const int t = r & 4095; const int pos = (fq < 2) ? (t >> 6) : (t & 63);
                    f32x4 c0 = (f32x4){1.f, 1.f, 1.f, 1.f}, c1 = c0, s0 = (f32x4){0.f, 0.f, 0.f, 0.f}, s1 = s0;
                    if (latent) { c0 = *(const f32x4*)(ropeC + pos * 16 + fb); c1 = *(const f32x4*)(ropeC + pos * 16 + fb + 4); s0 = *(const f32x4*)(ropeS + pos * 16 + fb); s1 = *(const f32x4*)(ropeS + pos * 16 + fb + 4); }
                    const f32x4 xa0 = acc[ai][0][m][0], xa1 = acc[ai][0][m][1], xb0 = acc[ai][1][m][0], xb1 = acc[ai][1][m][1];
                    const f32x4 y10 = (xa0 * c0 - xb0 * s0) * sc, y11 = (xa1 * c1 - xb1 * s1) * sc, y20 = (xb0 * c0 + xa0 * s0) * sc, y21 = (xb1 * c1 + xa1 * s1) * sc;
                    u32x4 w1, w2; w1.x = cvt_pk_bf16(y10[0], y10[1]); w1.y = cvt_pk_bf16(y10[2], y10[3]); w1.z = cvt_pk_bf16(y11[0], y11[1]); w1.w = cvt_pk_bf16(y11[2], y11[3]);
                    w2.x = cvt_pk_bf16(y20[0], y20[1]); w2.y = cvt_pk_bf16(y20[2], y20[3]); w2.z = cvt_pk_bf16(y21[0], y21[1]); w2.w = cvt_pk_bf16(y21[2], y21[3]);
                    bf16_t* rp = O + (size_t)r * 1280 + dst1; *(u32x4*)rp = w1; *(u32x4*)(rp + 32) = w2; }
        }
    }
};

template <class Epi, class Sched, bool ALIGN_EPI = false, bool SP2 = false>
__device__ __forceinline__ void gemm_phase(PG8_LAS unsigned char* lds, const Gemm g, const Sched& S, const Epi& E) {
    int tid_ = threadIdx.x; asm volatile("" : "+v"(tid_));
    const int tid = tid_, wid = __builtin_amdgcn_readfirstlane(tid >> 6), lane = tid & 63, wr = wid >> 2, wc = wid & 3, fr = lane & 15, fq = lane >> 4;
    const int K = g.K;
    unsigned voffA[2], voffB[2];
#pragma unroll
    for (int i = 0; i < 2; ++i) { int R, C; stage_rc(tid * 16 + i * 8192, R, C); const int Rb = Epi::PERM ? ((R & ~31) + perm32(R & 31)) : R;
        voffA[i] = (unsigned)(R * K + C) * 2u; voffB[i] = (unsigned)(Rb * K + C) * 2u; }
    const size_t kstep = (size_t)(BK * 2);
    const size_t hstep = (size_t)HALF * K * 2;
    const size_t tstep = 2 * hstep;
    const unsigned ldsw = (unsigned)wid * 1024u;
    const int aoff = lds_byte(wr * 64 + fr, fq * 8), boff = lds_byte(wc * 32 + fr, fq * 8);
#define PG8_SA(b, h) (((b) * 2 + (h)) * HTB)
#define PG8_SB(b, h) ((4 + (b) * 2 + (h)) * HTB)
#define PG8_STAGE(bufoff, gbase, voff) do { _Pragma("unroll") for (int _i = 0; _i < 2; ++_i) \
        __builtin_amdgcn_global_load_lds((const unsigned*)((const char*)(gbase) + (voff)[_i]), (PG8_LAS unsigned*)(lds + (bufoff) + ldsw + _i * 8192), 16, 0, 0); } while (0)
#define PG8_LDA(dst, b, h) do { _Pragma("unroll") for (int m = 0; m < 4; ++m) _Pragma("unroll") for (int k = 0; k < 2; ++k) dst[m][k] = *(const PG8_LAS bf16x8*)(lds + PG8_SA(b, h) + aoff + m * 2048 + k * 1024); } while (0)
#define PG8_LDB(dst, b, h) do { _Pragma("unroll") for (int n = 0; n < 2; ++n) _Pragma("unroll") for (int k = 0; k < 2; ++k) dst[n][k] = *(const PG8_LAS bf16x8*)(lds + PG8_SB(b, h) + boff + n * 2048 + k * 1024); } while (0)
#define PG8_MMA(ai, bj, At, Bt) do { __builtin_amdgcn_s_setprio(1); _Pragma("unroll") for (int m = 0; m < 4; ++m) _Pragma("unroll") for (int n = 0; n < 2; ++n) _Pragma("unroll") for (int k = 0; k < 2; ++k) \
        acc[ai][bj][m][n] = __builtin_amdgcn_mfma_f32_16x16x32_bf16(Bt[n][k], At[m][k], acc[ai][bj][m][n], 0, 0, 0); __builtin_amdgcn_s_setprio(0); } while (0)
#define PG8_WAIT_V(n) asm volatile("s_waitcnt vmcnt(" #n ")" ::: "memory")
#define PG8_WAIT_L(n) asm volatile("s_waitcnt lgkmcnt(" #n ")" ::: "memory")
#define PG8_BAR __builtin_amdgcn_s_barrier()
#define PG8_SCHED __builtin_amdgcn_sched_barrier(0)
    Unit cur, nxt; int ui = 0;
    if (!S.next(0, cur)) return;
    f32x4 acc[2][2][4][2];
#pragma unroll
    for (int a = 0; a < 2; ++a)
#pragma unroll
        for (int b = 0; b < 2; ++b)
#pragma unroll
            for (int m = 0; m < 4; ++m)
#pragma unroll
                for (int n = 0; n < 2; ++n) acc[a][b][m][n] = (f32x4){0.f, 0.f, 0.f, 0.f};
    bf16x8 At[4][2], B0[2][2], B1[2][2];
    const char* cA = (const char*)g.A + (size_t)cur.pm * tstep + (size_t)cur.k0 * kstep; const char* cB = (const char*)g.Bt + (size_t)cur.pn * tstep + (size_t)cur.k0 * kstep;
    S.a_ready(cur);
    if constexpr (SP2) {
        PG8_STAGE(PG8_SB(0, 0), cB, voffB); PG8_STAGE(PG8_SB(0, 1), cB + hstep, voffB); PG8_STAGE(PG8_SA(0, 0), cA, voffA); PG8_STAGE(PG8_SA(0, 1), cA + hstep, voffA);
        if (wr == 1) PG8_BAR;
        PG8_WAIT_V(2); PG8_BAR;
        PG8_STAGE(PG8_SB(1, 0), cB + kstep, voffB); PG8_STAGE(PG8_SA(1, 0), cA + kstep, voffA); PG8_STAGE(PG8_SB(1, 1), cB + hstep + kstep, voffB);
        PG8_WAIT_V(6); PG8_BAR;
    } else {
        PG8_STAGE(PG8_SB(0, 0), cB, voffB); PG8_STAGE(PG8_SA(0, 0), cA, voffA); PG8_STAGE(PG8_SB(0, 1), cB + hstep, voffB); PG8_STAGE(PG8_SA(0, 1), cA + hstep, voffA);
        if (wr == 1) PG8_BAR;
        PG8_WAIT_V(4); PG8_BAR;
        PG8_STAGE(PG8_SB(1, 0), cB + kstep, voffB); PG8_STAGE(PG8_SA(1, 0), cA + kstep, voffA); PG8_STAGE(PG8_SB(1, 1), cB + hstep + kstep, voffB);
        PG8_WAIT_V(6); PG8_BAR;
    }
    for (;;) {
        const bool has_next = S.next(ui + 1, nxt);
        const char* nA = has_next ? (const char*)g.A + (size_t)nxt.pm * tstep + (size_t)nxt.k0 * kstep : cA; const char* nB = has_next ? (const char*)g.Bt + (size_t)nxt.pn * tstep + (size_t)nxt.k0 * kstep : cB;
        const int nt = cur.nk;
        for (int t = 0; t < nt; t += 2) {
            const bool last = (t == nt - 2);
            const char* a1 = cA + (size_t)(t + 1) * kstep;
            const char* a2 = last ? nA : cA + (size_t)(t + 2) * kstep; const char* b2 = last ? nB : cB + (size_t)(t + 2) * kstep;
            const char* a3 = a2 + kstep; const char* b3 = b2 + kstep;
            if (last && has_next) S.a_ready(nxt);
            if constexpr (SP2) {
            PG8_LDB(B0, 0, 0); PG8_LDB(B1, 0, 1); PG8_SCHED; PG8_LDA(At, 0, 0); PG8_STAGE(PG8_SA(1, 1), a1 + hstep, voffA);
            PG8_WAIT_V(8); PG8_WAIT_L(0); PG8_BAR; PG8_MMA(0, 0, At, B0); PG8_MMA(0, 1, At, B1); PG8_BAR; PG8_SCHED;
            PG8_LDA(At, 0, 1); PG8_STAGE(PG8_SB(0, 0), b2, voffB); PG8_STAGE(PG8_SB(0, 1), b2 + hstep, voffB); PG8_STAGE(PG8_SA(0, 0), a2, voffA);
            PG8_WAIT_V(8); PG8_WAIT_L(0); PG8_BAR; PG8_MMA(1, 0, At, B0); PG8_MMA(1, 1, At, B1); PG8_BAR; PG8_SCHED;
            PG8_LDB(B0, 1, 0); PG8_LDB(B1, 1, 1); PG8_SCHED; PG8_LDA(At, 1, 0); PG8_STAGE(PG8_SA(0, 1), a2 + hstep, voffA);
            PG8_WAIT_V(8); PG8_WAIT_L(0); PG8_BAR; PG8_MMA(0, 0, At, B0); PG8_MMA(0, 1, At, B1); PG8_BAR; PG8_SCHED;
            PG8_LDA(At, 1, 1); PG8_STAGE(PG8_SB(1, 0), b3, voffB); PG8_STAGE(PG8_SB(1, 1), b3 + hstep, voffB); PG8_STAGE(PG8_SA(1, 0), a3, voffA);
            PG8_WAIT_V(8); PG8_WAIT_L(0); PG8_BAR; PG8_MMA(1, 0, At, B0); PG8_MMA(1, 1, At, B1); PG8_BAR; PG8_SCHED;
            } else {
            PG8_LDB(B0, 0, 0); PG8_SCHED; PG8_LDA(At, 0, 0); PG8_STAGE(PG8_SA(1, 1), a1 + hstep, voffA);
            PG8_WAIT_L(8); PG8_BAR; PG8_WAIT_L(0); PG8_MMA(0, 0, At, B0); PG8_BAR; PG8_SCHED;
            PG8_LDB(B1, 0, 1); PG8_STAGE(PG8_SB(0, 0), b2, voffB);
            PG8_BAR; PG8_WAIT_L(0); PG8_MMA(0, 1, At, B1); PG8_BAR;
            PG8_LDA(At, 0, 1); PG8_STAGE(PG8_SA(0, 0), a2, voffA);
            PG8_BAR; PG8_WAIT_L(0); PG8_MMA(1, 0, At, B0); PG8_BAR; PG8_SCHED;
            PG8_STAGE(PG8_SB(0, 1), b2 + hstep, voffB);
            PG8_WAIT_V(6); PG8_BAR; PG8_MMA(1, 1, At, B1); PG8_BAR;
            PG8_LDB(B0, 1, 0); PG8_SCHED; PG8_LDA(At, 1, 0); PG8_STAGE(PG8_SA(0, 1), a2 + hstep, voffA);
            PG8_WAIT_L(8); PG8_BAR; PG8_WAIT_L(0); PG8_MMA(0, 0, At, B0); PG8_BAR; PG8_SCHED;
            PG8_LDB(B1, 1, 1); PG8_STAGE(PG8_SB(1, 0), b3, voffB);
            PG8_BAR; PG8_WAIT_L(0); PG8_MMA(0, 1, At, B1); PG8_BAR;
            PG8_LDA(At, 1, 1); PG8_STAGE(PG8_SA(1, 0), a3, voffA);
            PG8_BAR; PG8_WAIT_L(0); PG8_MMA(1, 0, At, B0); PG8_BAR; PG8_SCHED;
            PG8_STAGE(PG8_SB(1, 1), b3 + hstep, voffB);
            PG8_WAIT_V(6); PG8_BAR; PG8_MMA(1, 1, At, B1); PG8_BAR;
            }
        }
        if constexpr (ALIGN_EPI) { if (wr == 0) PG8_BAR; }
        if constexpr (!Epi::AFTER_DRAIN) { E(acc, cur, wr, wc, fr, fq); S.done(cur); }
        if (!has_next) break;
#pragma unroll
        for (int a = 0; a < 2; ++a)
#pragma unroll
            for (int b = 0; b < 2; ++b)
#pragma unroll
                for (int m = 0; m < 4; ++m)
#pragma unroll
                    for (int n = 0; n < 2; ++n) acc[a][b][m][n] = (f32x4){0.f, 0.f, 0.f, 0.f};
        cur = nxt; cA = nA; cB = nB; ++ui;
        if constexpr (ALIGN_EPI) { if (wr == 1) PG8_BAR; }
    }
    PG8_WAIT_V(0);
    if constexpr (!ALIGN_EPI) { if (wr == 0) PG8_BAR; }
    PG8_BAR;
    if constexpr (Epi::AFTER_DRAIN) { E.fused(acc, cur, wr, wc, fr, fq, lds, wid, lane); S.done(cur); }
#undef PG8_SA
#undef PG8_SB
#undef PG8_STAGE
#undef PG8_LDA
#undef PG8_LDB
#undef PG8_MMA
#undef PG8_WAIT_V
#undef PG8_WAIT_L
#undef PG8_BAR
#undef PG8_SCHED
}
}

constexpr int D = 1024, NBATCH = 4, SEQ = 4096, ML = NBATCH * SEQ, CTXL = 256, MC = NBATCH * CTXL, MT = ML + MC, FF = 2816, NFF = 2 * FF, PW = 1280, NMODV = 9 * D;
constexpr int NWAVES = 8;
constexpr float C2 = 0.125f * 1.4426950408889634f;
typedef unsigned short bf16;
typedef unsigned v4u __attribute__((ext_vector_type(4)));
typedef unsigned v2u __attribute__((ext_vector_type(2)));
typedef float f32x4 __attribute__((ext_vector_type(4)));
typedef float f32x16 __attribute__((ext_vector_type(16)));
typedef short bf16x8 __attribute__((ext_vector_type(8)));
typedef short s16x4 __attribute__((ext_vector_type(4)));
#define LAS __attribute__((address_space(3)))
#define LDS_WAIT() asm volatile("s_waitcnt lgkmcnt(0)" ::: "memory")
constexpr size_t MiB = 1u << 20;
constexpr size_t WS_MODS = 0;
constexpr size_t WS_ROPE = 384 * 1024;
constexpr size_t WS_BAR = 448 * 1024;
constexpr size_t WS_W = 1 * MiB;
constexpr size_t W_F1IN = 0, W_F1OUT = W_F1IN + (size_t)NFF * D * 2, W_IN = W_F1OUT + (size_t)D * FF * 2, W_OUT = W_IN + (size_t)PW * D * 2, W_F2IN = W_OUT + (size_t)D * D * 2,
                 W_F2OUT = W_F2IN + (size_t)NFF * D * 2, LW_BYTES = W_F2OUT + (size_t)D * FF * 2;
constexpr size_t WS_H = WS_W + 2 * LW_BYTES;
constexpr size_t WS_XN = WS_H + (size_t)MT * D * 4;
constexpr size_t WS_ACT = WS_XN + (size_t)MT * D * 2;
constexpr size_t WS_END = WS_ACT + (size_t)MT * FF * 2;
static_assert(WS_W + 2 * LW_BYTES == 76 * MiB, "weights");

__device__ __forceinline__ unsigned f2bf(float f) { unsigned u = __builtin_bit_cast(unsigned, f); return (u + 0x7fffu + ((u >> 16) & 1u)) >> 16; }
__device__ __forceinline__ unsigned pk2(float lo, float hi) { return f2bf(lo) | (f2bf(hi) << 16); }
__device__ __forceinline__ float bf_lo(unsigned w) { return __builtin_bit_cast(float, w << 16); }
__device__ __forceinline__ float bf_hi(unsigned w) { return __builtin_bit_cast(float, w & 0xffff0000u); }
__device__ __forceinline__ float wave_sum(float v) {
#pragma unroll
    for (int o = 1; o < 64; o <<= 1) v += __shfl_xor(v, o);
    return v;
}
struct Frame { LAS unsigned char* lds; int tid, lane, wave, G, bid; };

__device__ __forceinline__ int src_swiglu(int n) { return ((n & 255) >> 7) * FF + (n >> 8) * 128 + (n & 127); }
__device__ __forceinline__ int src_qkv(int n) { const int pn = n >> 8, bj = (n >> 7) & 1, wc = (n >> 5) & 3, i = n & 31;
    if (pn < 2) return n; if (pn < 4 || wc < 2) return pn * 256 + wc * 64 + bj * 32 + i; return 1152 + bj * 64 + (wc - 2) * 32 + i; }
__device__ __forceinline__ void transpose_item(const float* W, int N, bf16* WT, int ldk, int kofs, int srcc0, int n0, int k0, LAS float* scr, int lane) {
#pragma unroll 8
    for (int i = 0; i < 32; ++i) { const int kk = 2 * i + (lane >> 5); scr[kk * 33 + (lane & 31)] = __builtin_nontemporal_load(W + (size_t)(k0 + kk) * N + srcc0 + (lane & 31)); }
    LDS_WAIT(); asm volatile("" ::: "memory");
    const int c = lane & 7;
#pragma unroll
    for (int j = 0; j < 4; ++j) { const int n = (lane >> 3) + 8 * j; const LAS float* s = scr + (8 * c) * 33 + n;
        v4u o; o.x = pk2(s[0 * 33], s[1 * 33]); o.y = pk2(s[2 * 33], s[3 * 33]); o.z = pk2(s[4 * 33], s[5 * 33]); o.w = pk2(s[6 * 33], s[7 * 33]);
        *(v4u*)(WT + (size_t)(n0 + n) * ldk + kofs + k0 + 8 * c) = o; }
    LDS_WAIT(); asm volatile("" ::: "memory");
}
__device__ __forceinline__ void fold_item(const float* wpool, const float* pscale, const float* wout, bf16* WoT, int g, int n0, LAS float* scr, int lane) {
#pragma unroll
    for (int i = 0; i < 4; ++i) { const int e = lane + 64 * i;
        const int d = e >> 1, h = e & 1; f32x4 v = *(const f32x4*)(wout + (size_t)(g * 128 + d) * D + n0 + 4 * h); v = v * pscale[g * 128 + d]; *(LAS f32x4*)(scr + d * 8 + 4 * h) = v; }
    LDS_WAIT(); asm volatile("" ::: "memory");
#pragma unroll 1
    for (int cc = 0; cc < 2; ++cc) { const int c = lane + 64 * cc; const float* wp = wpool + ((size_t)g * 128 + c) * 128;
        float acc[8];
#pragma unroll
        for (int n = 0; n < 8; ++n) acc[n] = 0.f;
#pragma unroll 2
        for (int d4 = 0; d4 < 32; ++d4) { const f32x4 w = *(const f32x4*)(wp + 4 * d4);
#pragma unroll
            for (int dd = 0; dd < 4; ++dd) { const f32x4 a = *(const LAS f32x4*)(scr + (4 * d4 + dd) * 8), b = *(const LAS f32x4*)(scr + (4 * d4 + dd) * 8 + 4);
                acc[0] += w[dd] * a[0]; acc[1] += w[dd] * a[1]; acc[2] += w[dd] * a[2]; acc[3] += w[dd] * a[3]; acc[4] += w[dd] * b[0]; acc[5] += w[dd] * b[1]; acc[6] += w[dd] * b[2]; acc[7] += w[dd] * b[3]; } }
#pragma unroll
        for (int n = 0; n < 8; ++n) WoT[(size_t)(n0 + n) * D + g * 128 + c] = (bf16)f2bf(acc[n]); }
    LDS_WAIT(); asm volatile("" ::: "memory");
}
struct In { const float *x, *c, *ctx, *c_ctx, *w_mod, *b_mod, *norm_ffn1, *w_ffn1_in, *w_ffn1_out, *norm_mix, *w_in, *w_pool, *pool_scale, *sink, *w_out, *norm_ffn2, *w_ffn2_in, *w_ffn2_out, *norm_final; };

__device__ __forceinline__ void prologue(const Frame& F, const In& I, unsigned char* ws) {
    float* mods = (float*)(ws + WS_MODS);
    {
        LAS float* sl = (LAS float*)F.lds;
        LAS float* red = (LAS float*)(F.lds + 20480);
        bool have = false;
        for (int it = F.bid; it < 72; it += F.G) {
            if (!have) { for (int e = F.tid; e < 5 * D; e += 512) { const float v = (e < 4 * D) ? I.c[e] : I.c_ctx[e - 4 * D]; sl[e] = v / (1.0f + __expf(-v)); } have = true; __syncthreads(); }
            const int l = it / 36, cgp = it % 36; const float* W = I.w_mod + (size_t)l * D * NMODV + cgp * 256 + 4 * F.lane;
            f32x4 acc[5];
#pragma unroll
            for (int b = 0; b < 5; ++b) acc[b] = (f32x4){0.f, 0.f, 0.f, 0.f};
            const int kb = F.wave * 128;
#pragma unroll 8
            for (int k = 0; k < 128; ++k) { const f32x4 w = __builtin_nontemporal_load((const f32x4*)(W + (size_t)(kb + k) * NMODV));
#pragma unroll
                for (int b = 0; b < 5; ++b) acc[b] += w * sl[b * D + kb + k]; }
#pragma unroll
            for (int b = 0; b < 5; ++b) *(LAS f32x4*)(red + (F.wave * 5 + b) * 256 + 4 * F.lane) = acc[b];
            __syncthreads();
            for (int e = F.tid; e < 5 * 256; e += 512) { const int b = e >> 8, cc = e & 255; float s = I.b_mod[(size_t)l * NMODV + cgp * 256 + cc];
#pragma unroll
                for (int w = 0; w < 8; ++w) s += red[(w * 5 + b) * 256 + cc];
                mods[((size_t)l * 5 + b) * NMODV + cgp * 256 + cc] = s; }
            __syncthreads();
        }
        __syncthreads();
    }
    LAS float* scr = (LAS float*)(F.lds + F.wave * 16384);
    const int gw = F.bid * NWAVES + F.wave, NGW = F.G * NWAVES;
    constexpr int I_FIN = (D / 64) * (NFF / 32), I_FOUT = (FF / 64) * (D / 32), I_IN = (D / 64) * (PW / 32), I_OUT = (512 / 64) * (D / 32), I_FOLD = 4 * (D / 8);
    constexpr int PER_L = 2 * I_FIN + 2 * I_FOUT + I_IN + I_OUT + I_FOLD, NITEMS = 2 * PER_L + 1;
    for (int it = gw; it < NITEMS; it += NGW) {
        if (it == 2 * PER_L) {
            float* rc = (float*)(ws + WS_ROPE); float* rs = rc + 1024;
            for (int f = 0; f < 16; ++f) { const float inv = powf(10000.0f, -(float)(2 * f) / 32.0f); const float a = (float)F.lane * inv; float s, c; sincosf(a, &s, &c); rc[F.lane * 16 + f] = c; rs[F.lane * 16 + f] = s; }
            continue;
        }
        const int l = it / PER_L; int r = it % PER_L; unsigned char* wl = ws + WS_W + (size_t)l * LW_BYTES;
        if (r < 2 * I_FIN) { const bool second = r >= I_FIN; if (second) r -= I_FIN; const float* W = (second ? I.w_ffn2_in : I.w_ffn1_in) + (size_t)l * D * NFF;
            const int nblk = NFF / 32, kb = r / nblk, nb = r % nblk; transpose_item(W, NFF, (bf16*)(wl + (second ? W_F2IN : W_F1IN)), D, 0, src_swiglu(32 * nb), 32 * nb, 64 * kb, scr, F.lane); continue; }
        r -= 2 * I_FIN;
        if (r < 2 * I_FOUT) { const bool second = r >= I_FOUT; if (second) r -= I_FOUT; const float* W = (second ? I.w_ffn2_out : I.w_ffn1_out) + (size_t)l * FF * D;
            const int nblk = D / 32, kb = r / nblk, nb = r % nblk; transpose_item(W, D, (bf16*)(wl + (second ? W_F2OUT : W_F1OUT)), FF, 0, 32 * nb, 32 * nb, 64 * kb, scr, F.lane); continue; }
        r -= 2 * I_FOUT;
        if (r < I_IN) { const float* W = I.w_in + (size_t)l * D * PW; const int nblk = PW / 32, kb = r / nblk, nb = r % nblk;
            transpose_item(W, PW, (bf16*)(wl + W_IN), D, 0, src_qkv(32 * nb), 32 * nb, 64 * kb, scr, F.lane); continue; }
        r -= I_IN;
        if (r < I_OUT) { const float* W = I.w_out + (size_t)l * D * D + (size_t)512 * D; const int nblk = D / 32, kb = r / nblk, nb = r % nblk;
            transpose_item(W, D, (bf16*)(wl + W_OUT), D, 512, 32 * nb, 32 * nb, 64 * kb, scr, F.lane); continue; }
        r -= I_OUT;
        { const int g = r / (D / 8), nb = r % (D / 8);
          fold_item(I.w_pool + (size_t)l * 4 * 128 * 128, I.pool_scale + (size_t)l * 512, I.w_out + (size_t)l * D * D, (bf16*)(wl + W_OUT), g, 8 * nb, scr, F.lane); }
    }
    { bf16* Hc = (bf16*)(ws + WS_H) + (size_t)ML * D; const int n4 = MC * D / 4;
      for (int e = F.bid * 512 + F.tid; e < n4; e += F.G * 512) { const f32x4 v = __builtin_nontemporal_load((const f32x4*)I.ctx + e); v2u w; w.x = pk2(v.x, v.y); w.y = pk2(v.z, v.w); ((v2u*)Hc)[e] = w; } }
}

template <bool NT = false> __device__ __forceinline__ void ld_row(const float* latf, const bf16* Hb, int m, int lane, f32x4 (&v)[4]) {
    if (latf != nullptr && m < ML) {
#pragma unroll
        for (int j = 0; j < 4; ++j) v[j] = __builtin_nontemporal_load((const f32x4*)(latf + (size_t)m * D + 4 * lane + 256 * j));
    } else {
#pragma unroll
        for (int j = 0; j < 4; ++j) { const v2u* p = (const v2u*)(Hb + (size_t)m * D + 4 * lane + 256 * j); const v2u w = NT ? __builtin_nontemporal_load(p) : *p; v[j] = (f32x4){bf_lo(w.x), bf_hi(w.x), bf_lo(w.y), bf_hi(w.y)}; } }
}
__device__ __forceinline__ void norm_phase(const Frame& F, const float* latf, bf16* Hb, bf16* XN, const float* g, const float* shift, const float* scale, int nrows, const bf16* slab, int nsplit) {
    const int gw = F.bid * NWAVES + F.wave, NGW = F.G * NWAVES; const int rpw = (ML + NGW - 1) / NGW;
    int m0 = gw * rpw, m1 = m0 + rpw; if (m1 > ML) m1 = ML; if (m0 > ML) m0 = ML;
    const int nctx = nrows - ML;
    int cur_b = -1; f32x4 gs[4], sh[4];
    for (int it = m0; it < m1 + 1; ++it) {
        int m = it;
        if (it == m1) { bool any = false; for (int r = gw; r < nctx; r += NGW) any = true; if (!any) break; m = ML + gw; }
        for (;; ) {
            const int b = m < ML ? (m >> 12) : 4;
            if (b != cur_b) { cur_b = b;
#pragma unroll
                for (int j = 0; j < 4; ++j) { const int col = 4 * F.lane + 256 * j; const f32x4 gv = *(const f32x4*)(g + col), sc = *(const f32x4*)(scale + (size_t)b * NMODV + col); gs[j] = gv * (sc + 1.0f); sh[j] = *(const f32x4*)(shift + (size_t)b * NMODV + col); } }
            f32x4 v[4]; float s = 0.f;
            ld_row(latf, Hb, m, F.lane, v);
            if (m >= ML && nsplit > 0) {
                const bf16* sp = slab + (size_t)(m - ML) * D + 4 * F.lane;
#pragma unroll 4
                for (int q = 0; q < nsplit; ++q) {
#pragma unroll
                    for (int j = 0; j < 4; ++j) { const v2u w = __builtin_nontemporal_load((const v2u*)(sp + (size_t)q * (MC * D) + 256 * j)); v[j] += (f32x4){bf_lo(w.x), bf_hi(w.x), bf_lo(w.y), bf_hi(w.y)}; } }
#pragma unroll
                for (int j = 0; j < 4; ++j) { v2u w; w.x = pk2(v[j].x, v[j].y); w.y = pk2(v[j].z, v[j].w); *(v2u*)(Hb + (size_t)m * D + 4 * F.lane + 256 * j) = w; }
            }
#pragma unroll
            for (int j = 0; j < 4; ++j) s += (v[j].x * v[j].x + v[j].y * v[j].y) + (v[j].z * v[j].z + v[j].w * v[j].w);
            const float rstd = 1.0f / sqrtf(wave_sum(s) * (1.0f / D) + 1e-6f);
            bf16* orow = XN + (size_t)m * D;
#pragma unroll
            for (int j = 0; j < 4; ++j) { const f32x4 o = v[j] * rstd * gs[j] + sh[j]; v2u w; w.x = pk2(o.x, o.y); w.y = pk2(o.z, o.w); *(v2u*)(orow + 4 * F.lane + 256 * j) = w; }
            if (m < ML) break;
            m += NGW; if (m >= ML + nctx) break;
        }
    }
}
__device__ __forceinline__ void final_norm(const Frame& F, const bf16* Hb, float* out, const float* g) {
    const int gw = F.bid * NWAVES + F.wave, NGW = F.G * NWAVES;
    f32x4 gv[4];
#pragma unroll
    for (int j = 0; j < 4; ++j) gv[j] = *(const f32x4*)(g + 4 * F.lane + 256 * j);
    for (int m = gw; m < ML; m += NGW) { f32x4 v[4]; float s = 0.f; ld_row<true>(nullptr, Hb, m, F.lane, v);
#pragma unroll
        for (int j = 0; j < 4; ++j) s += (v[j].x * v[j].x + v[j].y * v[j].y) + (v[j].z * v[j].z + v[j].w * v[j].w);
        const float rstd = 1.0f / sqrtf(wave_sum(s) * (1.0f / D) + 1e-6f);
#pragma unroll
        for (int j = 0; j < 4; ++j) __builtin_nontemporal_store(v[j] * rstd * gv[j], (f32x4*)(out + (size_t)m * D + 4 * F.lane + 256 * j)); }
}

constexpr int KROWB = 144;
constexpr int KBUF = 64 * KROWB;
__device__ __forceinline__ int crow(int r, int hi) { return (r & 3) + 8 * (r >> 2) + 4 * hi; }
__device__ __forceinline__ void attn_unit(const Frame& F, const bf16* QKV, bf16* MIX, const float* sink, int b, int kvh, int qt, bool isctx) {
    const int lane = F.lane, wid = F.wave, r32 = lane & 31, hi = lane >> 5, tid = F.tid;
    const int head = kvh * 4 + (wid >> 1), qh = wid & 1;
    const int qrow0 = isctx ? (ML + b * CTXL + qt * 64) : (b * SEQ + qt * 64);
    int lo = 0, nloc = 0;
    if (!isctx) { lo = qt - 2 < 0 ? 0 : qt - 2; const int hi_t = qt + 2 > 63 ? 63 : qt + 2; nloc = hi_t - lo + 1; }
    const int ntile = nloc + 4;
    bf16x8 qr[4];
    { const bf16* qp = QKV + (size_t)(qrow0 + 32 * qh + r32) * PW + 512 + head * 64 + hi * 8;
#pragma unroll
      for (int d0 = 0; d0 < 4; ++d0) qr[d0] = *(const bf16x8*)(qp + d0 * 16); }
    const int krow = tid >> 3, kch = tid & 7;
#define TILE_ROW(j) (((j) < nloc) ? (b * SEQ + (lo + (j)) * 64) : (ML + b * CTXL + ((j) - nloc) * 64))
#define LDK(j) (*(const v4u*)(QKV + (size_t)(TILE_ROW(j) + krow) * PW + 1024 + kvh * 64 + kch * 8))
#define LDV(j) (*(const v4u*)(QKV + (size_t)(TILE_ROW(j) + lane) * PW + 1152 + kvh * 64 + wid * 8))
    v4u kA = LDK(0), vA = LDV(0), kB = LDK(1), vB = LDV(1);
    float m_run = sink[head] * 1.4426950408889634f, l_run = (hi == 0) ? 1.0f : 0.0f;
    f32x16 o0 = {}, o1 = {};
    const int qpos = qt * 64 + 32 * qh + r32;
    auto stage = [&](int slot, const v4u& kreg, const v4u& vreg) __attribute__((always_inline)) {
        LAS unsigned char* kb = F.lds + slot * (2 * KBUF); LAS unsigned char* vb = kb + KBUF;
        *(LAS v4u*)(kb + krow * KROWB + kch * 16) = kreg;
        { LAS unsigned short* vt = (LAS unsigned short*)(vb + (wid * 8) * KROWB + lane * 2);
          vt[0 * (KROWB / 2)] = (unsigned short)(vreg.x & 0xffff); vt[1 * (KROWB / 2)] = (unsigned short)(vreg.x >> 16); vt[2 * (KROWB / 2)] = (unsigned short)(vreg.y & 0xffff); vt[3 * (KROWB / 2)] = (unsigned short)(vreg.y >> 16);
          vt[4 * (KROWB / 2)] = (unsigned short)(vreg.z & 0xffff); vt[5 * (KROWB / 2)] = (unsigned short)(vreg.z >> 16); vt[6 * (KROWB / 2)] = (unsigned short)(vreg.w & 0xffff); vt[7 * (KROWB / 2)] = (unsigned short)(vreg.w >> 16); }
    };
    auto compute = [&](int j, int slot) __attribute__((always_inline)) {
        LAS unsigned char* kb = F.lds + slot * (2 * KBUF); LAS unsigned char* vb = kb + KBUF;
        f32x16 p0 = {}, p1 = {};
#pragma unroll
        for (int d0 = 0; d0 < 4; ++d0) { const bf16x8 k0 = *(const LAS bf16x8*)(kb + r32 * KROWB + d0 * 32 + hi * 16), k1 = *(const LAS bf16x8*)(kb + (32 + r32) * KROWB + d0 * 32 + hi * 16);
            p0 = __builtin_amdgcn_mfma_f32_32x32x16_bf16(k0, qr[d0], p0, 0, 0, 0); p1 = __builtin_amdgcn_mfma_f32_32x32x16_bf16(k1, qr[d0], p1, 0, 0, 0); }
        if (j < nloc) { const int kbase = (lo + j) * 64 - qpos;
            const int dt = lo + j - qt;
            if (dt == -2 || dt == 2) {
#pragma unroll
                for (int r = 0; r < 16; ++r) { const int d0 = kbase + crow(r, hi), d1 = d0 + 32; if (d0 > 128 || d0 < -128) p0[r] = -1e30f; if (d1 > 128 || d1 < -128) p1[r] = -1e30f; } } }
        float mx = p0[0];
#pragma unroll
        for (int r = 1; r < 16; ++r) mx = fmaxf(mx, p0[r]);
#pragma unroll
        for (int r = 0; r < 16; ++r) mx = fmaxf(mx, p1[r]);
        mx = fmaxf(mx, __shfl_xor(mx, 32));
        const float mn = fmaxf(m_run, mx), alpha = __builtin_amdgcn_exp2f(m_run - mn); m_run = mn;
        float ps = 0.f;
#pragma unroll
        for (int r = 0; r < 16; ++r) { p0[r] = __builtin_amdgcn_exp2f(p0[r] - mn); p1[r] = __builtin_amdgcn_exp2f(p1[r] - mn); ps += p0[r] + p1[r]; }
        l_run = l_run * alpha + ps;
#pragma unroll
        for (int r = 0; r < 16; ++r) { o0[r] *= alpha; o1[r] *= alpha; }
#pragma unroll
        for (int c = 0; c < 4; ++c) {
            v4u pw;
            if (c == 0) { pw.x = pg8::cvt_pk_bf16(p0[0], p0[1]); pw.y = pg8::cvt_pk_bf16(p0[2], p0[3]); pw.z = pg8::cvt_pk_bf16(p0[4], p0[5]); pw.w = pg8::cvt_pk_bf16(p0[6], p0[7]); }
            else if (c == 1) { pw.x = pg8::cvt_pk_bf16(p0[8], p0[9]); pw.y = pg8::cvt_pk_bf16(p0[10], p0[11]); pw.z = pg8::cvt_pk_bf16(p0[12], p0[13]); pw.w = pg8::cvt_pk_bf16(p0[14], p0[15]); }
            else if (c == 2) { pw.x = pg8::cvt_pk_bf16(p1[0], p1[1]); pw.y = pg8::cvt_pk_bf16(p1[2], p1[3]); pw.z = pg8::cvt_pk_bf16(p1[4], p1[5]); pw.w = pg8::cvt_pk_bf16(p1[6], p1[7]); }
            else { pw.x = pg8::cvt_pk_bf16(p1[8], p1[9]); pw.y = pg8::cvt_pk_bf16(p1[10], p1[11]); pw.z = pg8::cvt_pk_bf16(p1[12], p1[13]); pw.w = pg8::cvt_pk_bf16(p1[14], p1[15]); }
            const bf16x8 pf = __builtin_bit_cast(bf16x8, pw);
#pragma unroll
            for (int dh = 0; dh < 2; ++dh) { const LAS unsigned char* vp = vb + (dh * 32 + r32) * KROWB + (16 * c + 4 * hi) * 2;
                const s16x4 a = *(const LAS s16x4*)vp, bq = *(const LAS s16x4*)(vp + 16);
                const bf16x8 vf = (bf16x8){a[0], a[1], a[2], a[3], bq[0], bq[1], bq[2], bq[3]};
                if (dh == 0) o0 = __builtin_amdgcn_mfma_f32_32x32x16_bf16(vf, pf, o0, 0, 0, 0); else o1 = __builtin_amdgcn_mfma_f32_32x32x16_bf16(vf, pf, o1, 0, 0, 0); }
        }
    };
    for (int j = 0, par = 0; j < ntile; j += 2, par ^= 2) {
        stage(par, kA, vA); if (j + 1 < ntile) stage(par + 1, kB, vB);
        asm volatile("s_waitcnt lgkmcnt(0)" ::: "memory"); __builtin_amdgcn_s_barrier(); asm volatile("" ::: "memory");
        if (j + 2 < ntile) { kA = LDK(j + 2); vA = LDV(j + 2); }
        if (j + 3 < ntile) { kB = LDK(j + 3); vB = LDV(j + 3); }
        compute(j, par); if (j + 1 < ntile) compute(j + 1, par + 1);
    }
#undef TILE_ROW
#undef LDK
#undef LDV
    const float lt = l_run + __shfl_xor(l_run, 32), inv = 1.0f / lt;
    bf16* op = MIX + (size_t)(qrow0 + 32 * qh + r32) * D + 512 + head * 64;
#pragma unroll
    for (int rq = 0; rq < 4; ++rq) { const int d = 8 * rq + 4 * hi;
        v2u w; w.x = pg8::cvt_pk_bf16(o0[4 * rq] * inv, o0[4 * rq + 1] * inv); w.y = pg8::cvt_pk_bf16(o0[4 * rq + 2] * inv, o0[4 * rq + 3] * inv); *(v2u*)(op + d) = w;
        w.x = pg8::cvt_pk_bf16(o1[4 * rq] * inv, o1[4 * rq + 1] * inv); w.y = pg8::cvt_pk_bf16(o1[4 * rq + 2] * inv, o1[4 * rq + 3] * inv); *(v2u*)(op + 32 + d) = w; }
    asm volatile("s_waitcnt lgkmcnt(0)" ::: "memory"); __builtin_amdgcn_s_barrier(); asm volatile("" ::: "memory");
}
template <int W> __device__ __forceinline__ void pool_seg(const bf16* QKV, bf16* MIX, int base, int Tn, int t0, int cc) {
    v4u rr[W + 7];
#pragma unroll
    for (int i = 0; i < W + 7; ++i) { const int tt = t0 - W / 2 + i; rr[i] = (v4u){0u, 0u, 0u, 0u}; if (tt >= 0 && tt < Tn) rr[i] = *(const v4u*)(QKV + (size_t)(base + tt) * PW + cc); }
#pragma unroll
    for (int r = 0; r < 8; ++r) { const int t = t0 + r; int lo = t - W / 2, hi = t + W - W / 2; if (lo < 0) lo = 0; if (hi > Tn) hi = Tn;
        float s[8];
#pragma unroll
        for (int i = 0; i < 8; ++i) s[i] = 0.f;
#pragma unroll
        for (int i = 0; i < W; ++i) { const v4u v = rr[r + i];
            s[0] += bf_lo(v.x); s[1] += bf_hi(v.x); s[2] += bf_lo(v.y); s[3] += bf_hi(v.y); s[4] += bf_lo(v.z); s[5] += bf_hi(v.z); s[6] += bf_lo(v.w); s[7] += bf_hi(v.w); }
        const float inv = 1.0f / (float)(hi - lo); const v4u u = rr[r + W / 2];
        v4u o; o.x = pk2(s[0] * inv - bf_lo(u.x), s[1] * inv - bf_hi(u.x)); o.y = pk2(s[2] * inv - bf_lo(u.y), s[3] * inv - bf_hi(u.y));
        o.z = pk2(s[4] * inv - bf_lo(u.z), s[5] * inv - bf_hi(u.z)); o.w = pk2(s[6] * inv - bf_lo(u.w), s[7] * inv - bf_hi(u.w));
        *(v4u*)(MIX + (size_t)(base + t) * D + cc) = o; }
}
__device__ __forceinline__ void pool_item(const Frame& F, const bf16* QKV, bf16* MIX, int r0) {
    int base, Tn; if (r0 < ML) { base = r0 & ~(SEQ - 1); Tn = SEQ; } else { base = ML + ((r0 - ML) & ~(CTXL - 1)); Tn = CTXL; }
    const int g = F.wave >> 1, cc = (g * 16 + (F.wave & 1) * 8 + (F.lane & 7)) * 8, t0 = (r0 - base) + (F.lane >> 3) * 8;
    if (g == 0) pool_seg<2>(QKV, MIX, base, Tn, t0, cc); else if (g == 1) pool_seg<4>(QKV, MIX, base, Tn, t0, cc); else if (g == 2) pool_seg<8>(QKV, MIX, base, Tn, t0, cc); else pool_seg<16>(QKV, MIX, base, Tn, t0, cc);
}
__device__ __forceinline__ void mixer_phase(const Frame& F, const bf16* QKV, bf16* MIX, const float* sink, bool do_ctx) {
    const int n_lat = NBATCH * 2 * 64, n_ctx = do_ctx ? NBATCH * 2 * 4 : 0, n_pool = (do_ctx ? MT : ML) / 64, total = n_lat + n_ctx + n_pool;
    for (int L = F.bid; L < total; L += F.G) {
        if (L < n_lat) { const int qt = L & 63, kvh = (L >> 6) & 1, b = L >> 7; attn_unit(F, QKV, MIX, sink, b, kvh, qt, false); }
        else if (L < n_lat + n_ctx) { const int u = L - n_lat; const int qt = u & 3, kvh = (u >> 2) & 1, b = u >> 3; attn_unit(F, QKV, MIX, sink, b, kvh, qt, true); }
        else pool_item(F, QKV, MIX, (L - n_lat - n_ctx) * 64);
    }
}

#define XB_TMO      128
#define XB_XCNT(j)  (256  + 64 * (j))
#define XB_XSUB(j)  (1280 + 64 * (j))
#define XB_XGEN(j)  (2304 + 64 * (j))
#define XB_TOP      3328
#define XB_TOPGEN   3392
#define XCD_BAR_WORDS 3456
#define XB_SPIN_CAP (1u << 18)

__device__ __forceinline__ unsigned xb_ld(unsigned* p)              { return __hip_atomic_load(p, __ATOMIC_RELAXED, __HIP_MEMORY_SCOPE_AGENT); }
__device__ __forceinline__ unsigned xb_add(unsigned* p, unsigned v) { return __hip_atomic_fetch_add(p, v, __ATOMIC_RELAXED, __HIP_MEMORY_SCOPE_AGENT); }
__device__ __forceinline__ unsigned xb_xcc_id() { return (unsigned)__builtin_amdgcn_s_getreg((3 << 11) | 20) & 0xFu; }
#define XB_SPIN(cond, bar) do { unsigned _sp = 0; while (cond) { __builtin_amdgcn_s_sleep(1); \
    if ((++_sp & 255u) == 0u) { if (xb_ld(&(bar)[XB_TMO])) break; if (_sp > XB_SPIN_CAP) { atomicAdd(&(bar)[XB_TMO], 1u); break; } } } } while (0)

struct XcdBarrier {
    unsigned* bar; unsigned x;
    volatile LAS unsigned* st;
};

__device__ __forceinline__ XcdBarrier xcd_barrier_post(unsigned* bar, volatile LAS unsigned* st) {
    XcdBarrier b; b.bar = bar; b.x = xb_xcc_id(); b.st = st;
    if (threadIdx.x == 0) (void)xb_add(&bar[XB_XCNT(b.x)], 1u);
    return b;
}
__device__ __forceinline__ void xcd_barrier_complete(unsigned* bar, unsigned x, unsigned& nloc, unsigned& nx) {
    const unsigned G = gridDim.x * gridDim.y * gridDim.z;
    unsigned sum, cnt, mine, sp = 0u;
    for (;;) {
        sum = 0u; cnt = 0u; mine = 0u;
#pragma unroll
        for (unsigned j = 0; j < 16; ++j) { const unsigned c = xb_ld(&bar[XB_XCNT(j)]); sum += c; cnt += (c > 0u) ? 1u : 0u; mine = (j == x) ? c : mine; }
        if (sum == G) break;
        __builtin_amdgcn_s_sleep(1);
        if ((++sp & 255u) == 0u) { if (xb_ld(&bar[XB_TMO])) break; if (sp > XB_SPIN_CAP) { atomicAdd(&bar[XB_TMO], 1u); break; } }
    }
    nloc = mine > 0u ? mine : 1u; nx = cnt > 0u ? cnt : 1u;
}

__device__ __forceinline__ void xcd_barrier(const XcdBarrier& b) {
    asm volatile("s_waitcnt vmcnt(0)" ::: "memory");
    __syncthreads();
    if (threadIdx.x == 0) {
        unsigned* bar = b.bar;
        __builtin_amdgcn_s_waitcnt(0);
        unsigned nloc = b.st[0], nx = b.st[1];
        if (nloc == 0u) { xcd_barrier_complete(bar, b.x, nloc, nx); b.st[0] = nloc; b.st[1] = nx; }
        const unsigned old = xb_add(&bar[XB_XSUB(b.x)], 1u);
        const unsigned gen = old / nloc;
        if (old + 1u == (gen + 1u) * nloc) {
            __builtin_amdgcn_fence(__ATOMIC_RELEASE, "agent");
            asm volatile("s_waitcnt vmcnt(0)" ::: "memory");
            const unsigned og = xb_add(&bar[XB_TOP], 1u);
            const unsigned tg = og / nx;
            if (og + 1u == (tg + 1u) * nx) xb_add(&bar[XB_TOPGEN], 1u);
            else XB_SPIN(xb_ld(&bar[XB_TOPGEN]) == tg, bar);
            __builtin_amdgcn_fence(__ATOMIC_ACQUIRE, "agent");
            xb_add(&bar[XB_XGEN(b.x)], 1u);
            asm volatile("s_waitcnt vmcnt(0)" ::: "memory");
        } else {
            XB_SPIN(xb_ld(&bar[XB_XGEN(b.x)]) == gen, bar);
            __builtin_amdgcn_fence(__ATOMIC_ACQUIRE, "agent");
            asm volatile("s_waitcnt vmcnt(0)" ::: "memory");
        }
    }
    __syncthreads();
}
#ifndef XP
#define XP 0
#endif
#define GSYNC() do { xcd_barrier(xbar); if (XP == 1) xcd_barrier(xbar); } while (0)
#define REPS(x) for (int rep_ = 0; rep_ < ((XP == (x)) ? 2 : 1); ++rep_)
#ifndef PHASES
#define PHASES 0xFFFF
#endif
#define PH(n) if (PHASES & (1 << (n)))
constexpr int LDS_BYTES = 147456;
struct Args { const void* p[21]; };
__device__ __forceinline__ const float* argf(const Args& a, int k) { asm volatile("" : "+s"(k)); return (const float*)a.p[k]; }
__device__ __forceinline__ unsigned char* argws(const Args& a) { int k = 20; asm volatile("" : "+s"(k)); return (unsigned char*)a.p[k]; }
#define MKFRAME() Frame F; F.lds = (LAS unsigned char*)lds; F.tid = threadIdx.x; asm volatile("" : "+v"(F.tid)); F.lane = F.tid & 63; F.wave = __builtin_amdgcn_readfirstlane(F.tid >> 6); F.G = gridDim.x; F.bid = blockIdx.x
__global__ void __launch_bounds__(NWAVES * 64, 2) fwd_megakernel(Args args) {
    extern __shared__ __attribute__((aligned(16))) unsigned char lds[];
    cg::grid_group grid = cg::this_grid();
    volatile LAS unsigned* xst = (volatile LAS unsigned*)((LAS unsigned char*)lds + 131072 + 64);
    if (threadIdx.x < 2) xst[threadIdx.x] = 0u;
    __syncthreads();
    const XcdBarrier xbar = xcd_barrier_post((unsigned*)(argws(args) + WS_BAR), xst);
    REPS(5) PH(0) { MKFRAME();
        In I; I.x = argf(args, 0); I.c = argf(args, 1); I.ctx = argf(args, 2); I.c_ctx = argf(args, 3); I.w_mod = argf(args, 4); I.b_mod = argf(args, 5); I.norm_ffn1 = argf(args, 6); I.w_ffn1_in = argf(args, 7); I.w_ffn1_out = argf(args, 8);
        I.norm_mix = argf(args, 9); I.w_in = argf(args, 10); I.w_pool = argf(args, 11); I.pool_scale = argf(args, 12); I.sink = argf(args, 13); I.w_out = argf(args, 14); I.norm_ffn2 = argf(args, 15); I.w_ffn2_in = argf(args, 16); I.w_ffn2_out = argf(args, 17); I.norm_final = argf(args, 18);
        prologue(F, I, argws(args)); }
    GSYNC();
    if (gridDim.x == 0x7fffffffu) grid.sync();
#pragma unroll 1
    for (int st = 0; st < 20; ++st) {
        const int l = st >= 10 ? 1 : 0, k = st - 10 * l;
        if (k == 0 || k == 3 || k == 7) { REPS(3) PH(1) { MKFRAME(); unsigned char* ws = argws(args); bf16* H = (bf16*)(ws + WS_H);
            const int j = (k == 0) ? 0 : (k == 3 ? 3 : 6); const float* ml = (const float*)(ws + WS_MODS) + (size_t)l * 5 * NMODV + j * D;
            const float* gw = argf(args, k == 0 ? 6 : (k == 3 ? 9 : 15)) + l * D;
            norm_phase(F, (st == 0) ? argf(args, 0) : nullptr, H, (bf16*)(ws + WS_XN), gw, ml, ml + D, (st == 17) ? ML : MT, (const bf16*)argf(args, 19), (st == 0 || st == 17) ? 0 : (k == 7 ? 4 : 11)); } }
        else if (k == 1 || k == 8) { REPS(6) PH(2) { unsigned char* ws = argws(args); unsigned char* wl = ws + WS_W + (size_t)l * LW_BYTES; const int nm = ((st == 18) ? ML : MT) / 256;
            pg8::Gemm g{(const bf16*)(ws + WS_XN), (const bf16*)(wl + (k == 1 ? W_F1IN : W_F2IN)), MT, NFF, D}; pg8::Sched<NFF / 256> S{nm, D / 64, (int)gridDim.x, (int)blockIdx.x, nm * (NFF / 256), 0, 1, 2};
            pg8::EpiSwiglu E{(bf16*)(ws + WS_ACT), FF}; pg8::gemm_phase<pg8::EpiSwiglu, pg8::Sched<NFF / 256>, true, true>((LAS unsigned char*)lds, g, S, E); } }
        else if (k == 2 || k == 6 || k == 9) { REPS(7) PH(3) { unsigned char* ws = argws(args); unsigned char* wl = ws + WS_W + (size_t)l * LW_BYTES; pg8::bf16_t* H = (pg8::bf16_t*)(ws + WS_H);
            const int j = (k == 2) ? 2 : (k == 6 ? 5 : 8); const float* gate = (const float*)(ws + WS_MODS) + (size_t)l * 5 * NMODV + j * D;
            const bool wo = (k == 6); const int nctx = (l == 1 && k != 2) ? 0 : 16; const bool nosplit = (XP == 2);
            pg8::Gemm g{(const bf16*)(ws + (wo ? WS_XN : WS_ACT)), (const bf16*)(wl + (k == 2 ? W_F1OUT : (wo ? W_OUT : W_F2OUT))), MT, D, wo ? D : FF};
            pg8::Sched<D / 256> S{ML / 256, (wo ? D : FF) / 64, (int)gridDim.x, (int)blockIdx.x, (ML / 256) * (D / 256), nosplit ? 0 : nctx, wo ? 4 : 11, 4}; if (nosplit) { S.nM = ML / 256 + nctx / 4; S.nmain = S.nM * 4; }
            pg8::EpiRes E{(st == 2 && rep_ == 0) ? argf(args, 0) : nullptr, H, gate, NMODV, (rep_ == 1) ? 0.0f : (wo ? 1.0f : 0.5f), (pg8::bf16_t*)argf(args, 19)}; pg8::gemm_phase<pg8::EpiRes, pg8::Sched<D / 256>, true, true>((LAS unsigned char*)lds, g, S, E); } }
        else if (k == 4) { REPS(8) PH(5) { unsigned char* ws = argws(args); unsigned char* wl = ws + WS_W + (size_t)l * LW_BYTES; const float* ropeC = (const float*)(ws + WS_ROPE);
            pg8::Gemm g{(const bf16*)(ws + WS_XN), (const bf16*)(wl + W_IN), MT, PW, D}; pg8::Sched<PW / 256> S{MT / 256, D / 64, (int)gridDim.x, (int)blockIdx.x, (MT / 256) * (PW / 256), 0, 1, 2};
            pg8::EpiQKV E{(bf16*)(ws + WS_ACT), ropeC, ropeC + 1024, C2}; pg8::gemm_phase<pg8::EpiQKV, pg8::Sched<PW / 256>, true, true>((LAS unsigned char*)lds, g, S, E); } }
        else { REPS(4) PH(6) { MKFRAME(); unsigned char* ws = argws(args); mixer_phase(F, (const bf16*)(ws + WS_ACT), (bf16*)(ws + WS_XN), argf(args, 13) + l * 8, l == 0); } }
        GSYNC();
    }
    PH(11) { MKFRAME(); unsigned char* ws = argws(args); int k = 19; asm volatile("" : "+s"(k)); final_norm(F, (const bf16*)(ws + WS_H), (float*)args.p[k], argf(args, 18)); }
}

extern "C" void kernel_launch(void* const* d_in, const int* in_sizes, int n_in, void* d_out, int out_size, void* d_ws, size_t ws_size, hipStream_t stream) {
    static int grid_blocks = 0;
    if (grid_blocks == 0) {
        if (n_in != 19 || out_size != ML * D || ws_size < WS_END) { fprintf(stderr, "kernel_launch: unexpected shapes (n_in %d, out %d, ws %zu < %zu)\n", n_in, out_size, ws_size, (size_t)WS_END); grid_blocks = -1; return; }
        int dev = 0, cus = 0, per_cu = 0;
        (void)hipGetDevice(&dev); (void)hipDeviceGetAttribute(&cus, hipDeviceAttributeMultiprocessorCount, dev);
        if (hipFuncSetAttribute((const void*)fwd_megakernel, hipFuncAttributeMaxDynamicSharedMemorySize, LDS_BYTES) != hipSuccess) { fprintf(stderr, "kernel_launch: hipFuncSetAttribute failed\n"); grid_blocks = -1; return; }
        if (hipOccupancyMaxActiveBlocksPerMultiprocessor(&per_cu, (const void*)fwd_megakernel, NWAVES * 64, LDS_BYTES) != hipSuccess || per_cu < 1) { fprintf(stderr, "kernel_launch: occupancy query gave %d\n", per_cu); per_cu = 1; }
        (void)hipGetLastError();
        grid_blocks = cus * per_cu;
    }
    if (grid_blocks < 0) return;
    if (hipMemsetAsync((char*)d_ws + WS_BAR, 0, XCD_BAR_WORDS * 4, stream) != hipSuccess) { fprintf(stderr, "kernel_launch: memset failed\n"); return; }
    Args a{};
    for (int i = 0; i < 19; ++i) a.p[i] = d_in[i];
    a.p[19] = d_out; a.p[20] = d_ws;
    void* kargs[] = {&a};
    hipError_t e = hipLaunchCooperativeKernel((const void*)fwd_megakernel, dim3(grid_blocks), dim3(NWAVES * 64), kargs, LDS_BYTES, stream);
    if (e != hipSuccess) fprintf(stderr, "kernel_launch: cooperative launch failed: %s (grid %d)\n", hipGetErrorString(e), grid_blocks);
}
```

```cpp
#include <hip/hip_runtime.h>
#include <hip/hip_cooperative_groups.h>
#include <cstdio>
#include <cstdint>
namespace cg = cooperative_groups;
namespace pg8 {
#define PG8_LAS __attribute__((address_space(3)))
typedef unsigned short bf16_t;
typedef short bf16x8 __attribute__((ext_vector_type(8)));
typedef float f32x4 __attribute__((ext_vector_type(4)));
typedef unsigned u32x4 __attribute__((ext_vector_type(4)));
constexpr int BM = 256, BK = 64, HALF = 128, HTB = HALF * BK * 2  , STAGE_BYTES = 8 * HTB, NXCD = 8, WGM = 8;

__host__ __device__ __forceinline__ int lds_byte(int r, int c) { const int st = (r >> 4) * 2 + (c >> 5), rr = r & 15, cc = c & 31, ob = rr * 64 + cc * 2; return st * 1024 + (ob ^ (((ob >> 9) & 1) << 5)); }
__host__ __device__ __forceinline__ void stage_rc(int b, int& R, int& C) { const int st = b / 1024, sb = b % 1024, swz = sb ^ (((sb >> 9) & 1) << 5); R = (st >> 1) * 16 + swz / 64; C = (st & 1) * 32 + (swz % 64) / 2; }
__host__ __device__ __forceinline__ int perm32(int rho) { const int n = rho >> 4, i = rho & 15; return 8 * (i >> 2) + 4 * n + (i & 3); }

struct Unit { int pm, pn, k0, nk, fl; };
struct Gemm { const bf16_t* A; const bf16_t* Bt; int M, N, K; };
typedef float f32x2_t __attribute__((ext_vector_type(2))); typedef __bf16 bf16x2_t __attribute__((ext_vector_type(2)));
__device__ __forceinline__ unsigned cvt_pk_bf16(float lo, float hi) { f32x2_t v = {lo, hi}; bf16x2_t b = __builtin_convertvector(v, bf16x2_t); return __builtin_bit_cast(unsigned, b); }
typedef float f32x2 __attribute__((ext_vector_type(2)));

template <int NN> __device__ __forceinline__ void tile_of(int L, int nM, int& pm, int& pn) {
    static_assert(NXCD == 8 && WGM == 8, "shifts below");
    const int nwg = nM * NN; int wgid = L;
    { const int q = nwg >> 3, r = nwg & 7, xcd = wgid & 7, off = wgid >> 3; wgid = (xcd < r ? xcd * (q + 1) : r * (q + 1) + (xcd - r) * q) + off; }
    constexpr int nig = WGM * NN; const int gid = wgid / nig, rem = wgid - gid * nig, fm = gid * WGM, gsz = (nM - fm) < WGM ? (nM - fm) : WGM;
    if (gsz == WGM) { pm = fm + (rem & 7); pn = rem >> 3; } else { pm = fm + rem % gsz; pn = rem / gsz; }
}
template <int NN> struct Sched {
    int nM, nkt, G, c, nmain, nctxu, nsplit, kper;
    __device__ __forceinline__ bool next(int i, Unit& u) const {
        const int L = i * G + c;
        if (L < nmain) { tile_of<NN>(L, nM, u.pm, u.pn); u.k0 = 0; u.nk = nkt; u.fl = 0; return true; }
        const int s = L - nmain; if (s >= nctxu * nsplit) return false;
        const int uu = s / nsplit, ks = s - uu * nsplit; u.pm = nM + uu / NN; u.pn = uu % NN; u.k0 = ks * kper; u.nk = kper; u.fl = 1; return true;
    }
    __device__ __forceinline__ void a_ready(const Unit&) const {}
    __device__ __forceinline__ void done(const Unit&) const {}
};
__device__ __forceinline__ float silu_mul(float a, float b) { const float e = __builtin_amdgcn_exp2f(a * -1.4426950408889634f); return a * b * __builtin_amdgcn_rcpf(1.0f + e); }
struct EpiSwiglu {
    static constexpr bool PERM = true, AFTER_DRAIN = false;
    bf16_t* O; int ldc;
    __device__ __forceinline__ void operator()(const f32x4 (&acc)[2][2][4][2], const Unit& u, int wr, int wc, int fr, int fq) const {
        const int row0 = u.pm * BM + wr * 64 + fr, col0 = u.pn * HALF + wc * 32 + 8 * fq;
#pragma unroll
        for (int ai = 0; ai < 2; ++ai)
#pragma unroll
            for (int m = 0; m < 4; ++m) { bf16_t* rowp = O + (size_t)(row0 + ai * HALF + m * 16) * ldc + col0;
                const f32x4 a0 = acc[ai][0][m][0], a1 = acc[ai][0][m][1], b0 = acc[ai][1][m][0], b1 = acc[ai][1][m][1];
                u32x4 w; w.x = cvt_pk_bf16(silu_mul(a0[0], b0[0]), silu_mul(a0[1], b0[1])); w.y = cvt_pk_bf16(silu_mul(a0[2], b0[2]), silu_mul(a0[3], b0[3]));
                w.z = cvt_pk_bf16(silu_mul(a1[0], b1[0]), silu_mul(a1[1], b1[1])); w.w = cvt_pk_bf16(silu_mul(a1[2], b1[2]), silu_mul(a1[3], b1[3]));
                *(u32x4*)rowp = w; }
    }
};
struct EpiRes {
    static constexpr bool PERM = true, AFTER_DRAIN = false;
    const float* basef; bf16_t* Hb; const float* gate; int gstride; float coef; bf16_t* slab;
    __device__ __forceinline__ void operator()(const f32x4 (&acc)[2][2][4][2], const Unit& u, int wr, int wc, int fr, int fq) const {
        const int bidx = u.pm < 64 ? (u.pm >> 4) : 4; const float* gp = gate + (size_t)bidx * gstride;
        const int col0 = u.pn * BM + wc * 32 + 8 * fq;
        f32x4 gv[2][2];
#pragma unroll
        for (int bj = 0; bj < 2; ++bj)
#pragma unroll
            for (int n = 0; n < 2; ++n) gv[bj][n] = *(const f32x4*)(gp + col0 + bj * HALF + n * 4) * coef;
        const bool f32base = (basef != nullptr) && (u.pm < 64);
#pragma unroll
        for (int ai = 0; ai < 2; ++ai)
#pragma unroll
            for (int m = 0; m < 4; ++m) { const size_t off = (size_t)(u.pm * BM + ai * HALF + wr * 64 + m * 16 + fr) * 1024 + col0;
#pragma unroll
                for (int bj = 0; bj < 2; ++bj) { const size_t o = off + bj * HALF; const f32x4 v0 = acc[ai][bj][m][0] * gv[bj][0], v1 = acc[ai][bj][m][1] * gv[bj][1];
                    if (u.fl) { u32x4 w; w.x = cvt_pk_bf16(v0[0], v0[1]); w.y = cvt_pk_bf16(v0[2], v0[3]); w.z = cvt_pk_bf16(v1[0], v1[1]); w.w = cvt_pk_bf16(v1[2], v1[3]);
                        *(u32x4*)(slab + (size_t)(u.k0 >> 2) * (1024 * 1024) + (o - (size_t)16384 * 1024)) = w; }
                    else { f32x4 b0, b1;
                        if (f32base) { b0 = __builtin_nontemporal_load((const f32x4*)(basef + o)); b1 = __builtin_nontemporal_load((const f32x4*)(basef + o + 4)); }
                        else { const u32x4 w = *(const u32x4*)(Hb + o); b0 = (f32x4){__builtin_bit_cast(float, w.x << 16), __builtin_bit_cast(float, w.x & 0xffff0000u), __builtin_bit_cast(float, w.y << 16), __builtin_bit_cast(float, w.y & 0xffff0000u)};
                            b1 = (f32x4){__builtin_bit_cast(float, w.z << 16), __builtin_bit_cast(float, w.z & 0xffff0000u), __builtin_bit_cast(float, w.w << 16), __builtin_bit_cast(float, w.w & 0xffff0000u)}; }
                        b0 += v0; b1 += v1; u32x4 w; w.x = cvt_pk_bf16(b0[0], b0[1]); w.y = cvt_pk_bf16(b0[2], b0[3]); w.z = cvt_pk_bf16(b1[0], b1[1]); w.w = cvt_pk_bf16(b1[2], b1[3]);
                        *(u32x4*)(Hb + o) = w; } } }
    }
};
struct EpiQKV {
    static constexpr bool PERM = true, AFTER_DRAIN = false;
    bf16_t* O; const float* ropeC; const float* ropeS; float qscale;
    __device__ __forceinline__ void operator()(const f32x4 (&acc)[2][2][4][2], const Unit& u, int wr, int wc, int fr, int fq) const {
        const int row0 = u.pm * BM + wr * 64 + fr; const bool latent = u.pm < 64;
        if (u.pn < 2 || (u.pn == 4 && wc >= 2)) {
#pragma unroll
            for (int bj = 0; bj < 2; ++bj) { const int col = (u.pn < 2) ? (u.pn * BM + bj * HALF + wc * 32 + 8 * fq) : (1152 + bj * 64 + (wc - 2) * 32 + 8 * fq);
#pragma unroll
                for (int ai = 0; ai < 2; ++ai)
#pragma unroll
                    for (int m = 0; m < 4; ++m) { const f32x4 v0 = acc[ai][bj][m][0], v1 = acc[ai][bj][m][1];
                        u32x4 w; w.x = cvt_pk_bf16(v0[0], v0[1]); w.y = cvt_pk_bf16(v0[2], v0[3]); w.z = cvt_pk_bf16(v1[0], v1[1]); w.w = cvt_pk_bf16(v1[2], v1[3]);
                        *(u32x4*)(O + (size_t)(row0 + ai * HALF + m * 16) * 1280 + col) = w; } }
        } else {
            const int dst1 = u.pn * BM + wc * 64 + 8 * fq; const float sc = (u.pn < 4) ? qscale : 1.0f; const int fb = 8 * (fq & 1);
#pragma unroll
            for (int ai = 0; ai < 2; ++ai)
#pragma unroll
                for (int m = 0; m < 4; ++m) { const int r = row0 + ai * HALF + m * 16; const int t = r & 4095; const int pos = (fq < 2) ? (t >> 6) : (t & 63);
                    f32x4 c0 = (f32x4){1.f, 1.f, 1.f, 1.f}, c1 = c0, s0 = (f32x4){0.f, 0.f, 0.f, 0.f}, s1 = s0;
                    if (latent) {
                        const float ps = (float)pos * ((fb != 0) ? 0.01f : 1.0f);
                        const float r0 = ps * 0.15915494309f, r1 = ps * 0.08949846255f, r2 = ps * 0.05032921210f, r3 = ps * 0.02830225515f, r4 = ps * 0.01591549431f, r5 = ps * 0.00894984626f, r6 = ps * 0.00503292121f, r7 = ps * 0.00283022552f;
                        c0 = (f32x4){__builtin_amdgcn_cosf(r0), __builtin_amdgcn_cosf(r1), __builtin_amdgcn_cosf(r2), __builtin_amdgcn_cosf(r3)}; c1 = (f32x4){__builtin_amdgcn_cosf(r4), __builtin_amdgcn_cosf(r5), __builtin_amdgcn_cosf(r6), __builtin_amdgcn_cosf(r7)};
                        s0 = (f32x4){__builtin_amdgcn_sinf(r0), __builtin_amdgcn_sinf(r1), __builtin_amdgcn_sinf(r2), __builtin_amdgcn_sinf(r3)}; s1 = (f32x4){__builtin_amdgcn_sinf(r4), __builtin_amdgcn_sinf(r5), __builtin_amdgcn_sinf(r6), __builtin_amdgcn_sinf(r7)}; }
                    const f32x4 xa0 = acc[ai][0][m][0], xa1 = acc[ai][0][m][1], xb0 = acc[ai][1][m][0], xb1 = acc[ai][1][m][1];
                    const f32x4 y10 = (xa0 * c0 - xb0 * s0) * sc, y11 = (xa1 * c1 - xb1 * s1) * sc, y20 = (xb0 * c0 + xa0 * s0) * sc, y21 = (xb1 * c1 + xa1 * s1) * sc;
                    u32x4 w1, w2; w1.x = cvt_pk_bf16(y10[0], y10[1]); w1.y = cvt_pk_bf16(y10[2], y10[3]); w1.z = cvt_pk_bf16(y11[0], y11[1]); w1.w = cvt_pk_bf16(y11[2], y11[3]);
                    w2.x = cvt_pk_bf16(y20[0], y20[1]); w2.y = cvt_pk_bf16(y20[2], y20[3]); w2.z = cvt_pk_bf16(y21[0], y21[1]); w2.w = cvt_pk_bf16(y21[2], y21[3]);
                    bf16_t* rp = O + (size_t)r * 1280 + dst1; *(u32x4*)rp = w1; *(u32x4*)(rp + 32) = w2; }
        }
    }
};

template <class Epi, class Sched, bool ALIGN_EPI = false, bool SP2 = false>
__device__ __forceinline__ void gemm_phase(PG8_LAS unsigned char* lds, const Gemm g, const Sched& S, const Epi& E) {
    int tid_ = threadIdx.x; asm volatile("" : "+v"(tid_));
    const int tid = tid_, wid = __builtin_amdgcn_readfirstlane(tid >> 6), lane = tid & 63, wr = wid >> 2, wc = wid & 3, fr = lane & 15, fq = lane >> 4;
    const int K = g.K;
    unsigned voffA[2], voffB[2];
#pragma unroll
    for (int i = 0; i < 2; ++i) { int R, C; stage_rc(tid * 16 + i * 8192, R, C); const int Rb = Epi::PERM ? ((R & ~31) + perm32(R & 31)) : R;
        voffA[i] = (unsigned)(R * K + C) * 2u; voffB[i] = (unsigned)(Rb * K + C) * 2u; }
    const size_t kstep = (size_t)(BK * 2);
    const size_t hstep = (size_t)HALF * K * 2;
    const size_t tstep = 2 * hstep;
    const unsigned ldsw = (unsigned)wid * 1024u;
    const int aoff = lds_byte(wr * 64 + fr, fq * 8), boff = lds_byte(wc * 32 + fr, fq * 8);
#define PG8_SA(b, h) (((b) * 2 + (h)) * HTB)
#define PG8_SB(b, h) ((4 + (b) * 2 + (h)) * HTB)
#define PG8_STAGE(bufoff, gbase, voff) do { _Pragma("unroll") for (int _i = 0; _i < 2; ++_i) \
        __builtin_amdgcn_global_load_lds((const unsigned*)((const char*)(gbase) + (voff)[_i]), (PG8_LAS unsigned*)(lds + (bufoff) + ldsw + _i * 8192), 16, 0, 0); } while (0)
#define PG8_LDA(dst, b, h) do { _Pragma("unroll") for (int m = 0; m < 4; ++m) _Pragma("unroll") for (int k = 0; k < 2; ++k) dst[m][k] = *(const PG8_LAS bf16x8*)(lds + PG8_SA(b, h) + aoff + m * 2048 + k * 1024); } while (0)
#define PG8_LDB(dst, b, h) do { _Pragma("unroll") for (int n = 0; n < 2; ++n) _Pragma("unroll") for (int k = 0; k < 2; ++k) dst[n][k] = *(const PG8_LAS bf16x8*)(lds + PG8_SB(b, h) + boff + n * 2048 + k * 1024); } while (0)
#define PG8_MMA(ai, bj, At, Bt) do { __builtin_amdgcn_s_setprio(1); _Pragma("unroll") for (int m = 0; m < 4; ++m) _Pragma("unroll") for (int n = 0; n < 2; ++n) _Pragma("unroll") for (int k = 0; k < 2; ++k) \
        acc[ai][bj][m][n] = __builtin_amdgcn_mfma_f32_16x16x32_bf16(Bt[n][k], At[m][k], acc[ai][bj][m][n], 0, 0, 0); __builtin_amdgcn_s_setprio(0); } while (0)
#define PG8_WAIT_V(n) asm volatile("s_waitcnt vmcnt(" #n ")" ::: "memory")
#define PG8_WAIT_L(n) asm volatile("s_waitcnt lgkmcnt(" #n ")" ::: "memory")
#define PG8_BAR __builtin_amdgcn_s_barrier()
#define PG8_SCHED __builtin_amdgcn_sched_barrier(0)
    Unit cur, nxt; int ui = 0;
    if (!S.next(0, cur)) return;
    f32x4 acc[2][2][4][2];
#pragma unroll
    for (int a = 0; a < 2; ++a)
#pragma unroll
        for (int b = 0; b < 2; ++b)
#pragma unroll
            for (int m = 0; m < 4; ++m)
#pragma unroll
                for (int n = 0; n < 2; ++n) acc[a][b][m][n] = (f32x4){0.f, 0.f, 0.f, 0.f};
    bf16x8 At[4][2], B0[2][2], B1[2][2];
    const char* cA = (const char*)g.A + (size_t)cur.pm * tstep + (size_t)cur.k0 * kstep; const char* cB = (const char*)g.Bt + (size_t)cur.pn * tstep + (size_t)cur.k0 * kstep;
    S.a_ready(cur);
    if constexpr (SP2) {
        PG8_STAGE(PG8_SB(0, 0), cB, voffB); PG8_STAGE(PG8_SB(0, 1), cB + hstep, voffB); PG8_STAGE(PG8_SA(0, 0), cA, voffA); PG8_STAGE(PG8_SA(0, 1), cA + hstep, voffA);
        if (wr == 1) PG8_BAR;
        PG8_WAIT_V(2); PG8_BAR;
        PG8_STAGE(PG8_SB(1, 0), cB + kstep, voffB); PG8_STAGE(PG8_SA(1, 0), cA + kstep, voffA); PG8_STAGE(PG8_SB(1, 1), cB + hstep + kstep, voffB);
        PG8_WAIT_V(6); PG8_BAR;
    } else {
        PG8_STAGE(PG8_SB(0, 0), cB, voffB); PG8_STAGE(PG8_SA(0, 0), cA, voffA); PG8_STAGE(PG8_SB(0, 1), cB + hstep, voffB); PG8_STAGE(PG8_SA(0, 1), cA + hstep, voffA);
        if (wr == 1) PG8_BAR;
        PG8_WAIT_V(4); PG8_BAR;
        PG8_STAGE(PG8_SB(1, 0), cB + kstep, voffB); PG8_STAGE(PG8_SA(1, 0), cA + kstep, voffA); PG8_STAGE(PG8_SB(1, 1), cB + hstep + kstep, voffB);
        PG8_WAIT_V(6); PG8_BAR;
    }
    for (;;) {
        const bool has_next = S.next(ui + 1, nxt);
        const char* nA = has_next ? (const char*)g.A + (size_t)nxt.pm * tstep + (size_t)nxt.k0 * kstep : cA; const char* nB = has_next ? (const char*)g.Bt + (size_t)nxt.pn * tstep + (size_t)nxt.k0 * kstep : cB;
        const int nt = cur.nk;
        for (int t = 0; t < nt; t += 2) {
            const bool last = (t == nt - 2);
            const char* a1 = cA + (size_t)(t + 1) * kstep;
            const char* a2 = last ? nA : cA + (size_t)(t + 2) * kstep; const char* b2 = last ? nB : cB + (size_t)(t + 2) * kstep;
            const char* a3 = a2 + kstep; const char* b3 = b2 + kstep;
            if (last && has_next) S.a_ready(nxt);
            if constexpr (SP2) {
            PG8_LDB(B0, 0, 0); PG8_LDB(B1, 0, 1); PG8_SCHED; PG8_LDA(At, 0, 0); PG8_STAGE(PG8_SA(1, 1), a1 + hstep, voffA);
            PG8_WAIT_V(8); PG8_WAIT_L(0); PG8_BAR; PG8_MMA(0, 0, At, B0); PG8_MMA(0, 1, At, B1); PG8_BAR; PG8_SCHED;
            PG8_LDA(At, 0, 1); PG8_STAGE(PG8_SB(0, 0), b2, voffB); PG8_STAGE(PG8_SB(0, 1), b2 + hstep, voffB); PG8_STAGE(PG8_SA(0, 0), a2, voffA);
            PG8_WAIT_V(8); PG8_WAIT_L(0); PG8_BAR; PG8_MMA(1, 0, At, B0); PG8_MMA(1, 1, At, B1); PG8_BAR; PG8_SCHED;
            PG8_LDB(B0, 1, 0); PG8_LDB(B1, 1, 1); PG8_SCHED; PG8_LDA(At, 1, 0); PG8_STAGE(PG8_SA(0, 1), a2 + hstep, voffA);
            PG8_WAIT_V(8); PG8_WAIT_L(0); PG8_BAR; PG8_MMA(0, 0, At, B0); PG8_MMA(0, 1, At, B1); PG8_BAR; PG8_SCHED;
            PG8_LDA(At, 1, 1); PG8_STAGE(PG8_SB(1, 0), b3, voffB); PG8_STAGE(PG8_SB(1, 1), b3 + hstep, voffB); PG8_STAGE(PG8_SA(1, 0), a3, voffA);
            PG8_WAIT_V(8); PG8_WAIT_L(0); PG8_BAR; PG8_MMA(1, 0, At, B0); PG8_MMA(1, 1, At, B1); PG8_BAR; PG8_SCHED;
            } else {
            PG8_LDB(B0, 0, 0); PG8_SCHED; PG8_LDA(At, 0, 0); PG8_STAGE(PG8_SA(1, 1), a1 + hstep, voffA);
            PG8_WAIT_L(8); PG8_BAR; PG8_WAIT_L(0); PG8_MMA(0, 0, At, B0); PG8_BAR; PG8_SCHED;
            PG8_LDB(B1, 0, 1); PG8_STAGE(PG8_SB(0, 0), b2, voffB);
            PG8_BAR; PG8_WAIT_L(0); PG8_MMA(0, 1, At, B1); PG8_BAR;
            PG8_LDA(At, 0, 1); PG8_STAGE(PG8_SA(0, 0), a2, voffA);
            PG8_BAR; PG8_WAIT_L(0); PG8_MMA(1, 0, At, B0); PG8_BAR; PG8_SCHED;
            PG8_STAGE(PG8_SB(0, 1), b2 + hstep, voffB);
            PG8_WAIT_V(6); PG8_BAR; PG8_MMA(1, 1, At, B1); PG8_BAR;
            PG8_LDB(B0, 1, 0); PG8_SCHED; PG8_LDA(At, 1, 0); PG8_STAGE(PG8_SA(0, 1), a2 + hstep, voffA);
            PG8_WAIT_L(8); PG8_BAR; PG8_WAIT_L(0); PG8_MMA(0, 0, At, B0); PG8_BAR; PG8_SCHED;
            PG8_LDB(B1, 1, 1); PG8_STAGE(PG8_SB(1, 0), b3, voffB);
            PG8_BAR; PG8_WAIT_L(0); PG8_MMA(0, 1, At, B1); PG8_BAR;
            PG8_LDA(At, 1, 1); PG8_STAGE(PG8_SA(1, 0), a3, voffA);
            PG8_BAR; PG8_WAIT_L(0); PG8_MMA(1, 0, At, B0); PG8_BAR; PG8_SCHED;
            PG8_STAGE(PG8_SB(1, 1), b3 + hstep, voffB);
            PG8_WAIT_V(6); PG8_BAR; PG8_MMA(1, 1, At, B1); PG8_BAR;
            }
        }
        if constexpr (ALIGN_EPI) { if (wr == 0) PG8_BAR; }
        if constexpr (!Epi::AFTER_DRAIN) { E(acc, cur, wr, wc, fr, fq); S.done(cur); }
        if (!has_next) break;
#pragma unroll
        for (int a = 0; a < 2; ++a)
#pragma unroll
            for (int b = 0; b < 2; ++b)
#pragma unroll
                for (int m = 0; m < 4; ++m)
#pragma unroll
                    for (int n = 0; n < 2; ++n) acc[a][b][m][n] = (f32x4){0.f, 0.f, 0.f, 0.f};
        cur = nxt; cA = nA; cB = nB; ++ui;
        if constexpr (ALIGN_EPI) { if (wr == 1) PG8_BAR; }
    }
    PG8_WAIT_V(0);
    if constexpr (!ALIGN_EPI) { if (wr == 0) PG8_BAR; }
    PG8_BAR;
    if constexpr (Epi::AFTER_DRAIN) { E.fused(acc, cur, wr, wc, fr, fq, lds, wid, lane); S.done(cur); }
#undef PG8_SA
#undef PG8_SB
#undef PG8_STAGE
#undef PG8_LDA
#undef PG8_LDB
#undef PG8_MMA
#undef PG8_WAIT_V
#undef PG8_WAIT_L
#undef PG8_BAR
#undef PG8_SCHED
}
}

constexpr int D = 1024, NBATCH = 4, SEQ = 4096, ML = NBATCH * SEQ, CTXL = 256, MC = NBATCH * CTXL, MT = ML + MC, FF = 2816, NFF = 2 * FF, PW = 1280, NMODV = 9 * D;
constexpr int NWAVES = 8;
constexpr float C2 = 0.125f * 1.4426950408889634f;
typedef unsigned short bf16;
typedef unsigned v4u __attribute__((ext_vector_type(4)));
typedef unsigned v2u __attribute__((ext_vector_type(2)));
typedef float f32x4 __attribute__((ext_vector_type(4)));
typedef float f32x16 __attribute__((ext_vector_type(16)));
typedef short bf16x8 __attribute__((ext_vector_type(8)));
typedef short s16x4 __attribute__((ext_vector_type(4)));
#define LAS __attribute__((address_space(3)))
#define LDS_WAIT() asm volatile("s_waitcnt lgkmcnt(0)" ::: "memory")
constexpr size_t MiB = 1u << 20;
constexpr size_t WS_MODS = 0;
constexpr size_t WS_ROPE = 384 * 1024;
constexpr size_t WS_BAR = 448 * 1024;
constexpr size_t WS_W = 1 * MiB;
constexpr size_t W_F1IN = 0, W_F1OUT = W_F1IN + (size_t)NFF * D * 2, W_IN = W_F1OUT + (size_t)D * FF * 2, W_OUT = W_IN + (size_t)PW * D * 2, W_F2IN = W_OUT + (size_t)D * D * 2,
                 W_F2OUT = W_F2IN + (size_t)NFF * D * 2, LW_BYTES = W_F2OUT + (size_t)D * FF * 2;
constexpr size_t WS_H = WS_W + 2 * LW_BYTES;
constexpr size_t WS_XN = WS_H + (size_t)MT * D * 4;
constexpr size_t WS_ACT = WS_XN + (size_t)MT * D * 2;
constexpr size_t WS_END = WS_ACT + (size_t)MT * FF * 2;
static_assert(WS_W + 2 * LW_BYTES == 76 * MiB, "weights");

__device__ __forceinline__ unsigned f2bf(float f) { unsigned u = __builtin_bit_cast(unsigned, f); return (u + 0x7fffu + ((u >> 16) & 1u)) >> 16; }
__device__ __forceinline__ unsigned pk2(float lo, float hi) { return f2bf(lo) | (f2bf(hi) << 16); }
__device__ __forceinline__ float bf_lo(unsigned w) { return __builtin_bit_cast(float, w << 16); }
__device__ __forceinline__ float bf_hi(unsigned w) { return __builtin_bit_cast(float, w & 0xffff0000u); }
__device__ __forceinline__ float wave_sum(float v) {
#pragma unroll
    for (int o = 1; o < 64; o <<= 1) v += __shfl_xor(v, o);
    return v;
}
struct Frame { LAS unsigned char* lds; int tid, lane, wave, G, bid; };

__device__ __forceinline__ int src_swiglu(int n) { return ((n & 255) >> 7) * FF + (n >> 8) * 128 + (n & 127); }
__device__ __forceinline__ int src_qkv(int n) { const int pn = n >> 8, bj = (n >> 7) & 1, wc = (n >> 5) & 3, i = n & 31;
    if (pn < 2) return n; if (pn < 4 || wc < 2) return pn * 256 + wc * 64 + bj * 32 + i; return 1152 + bj * 64 + (wc - 2) * 32 + i; }
__device__ __forceinline__ void transpose_item(const float* W, int N, bf16* WT, int ldk, int kofs, int srcc0, int n0, int k0, LAS float* scr, int lane) {
#pragma unroll 8
    for (int i = 0; i < 32; ++i) { const int kk = 2 * i + (lane >> 5); scr[kk * 33 + (lane & 31)] = __builtin_nontemporal_load(W + (size_t)(k0 + kk) * N + srcc0 + (lane & 31)); }
    LDS_WAIT(); asm volatile("" ::: "memory");
    const int c = lane & 7;
#pragma unroll
    for (int j = 0; j < 4; ++j) { const int n = (lane >> 3) + 8 * j; const LAS float* s = scr + (8 * c) * 33 + n;
        v4u o; o.x = pk2(s[0 * 33], s[1 * 33]); o.y = pk2(s[2 * 33], s[3 * 33]); o.z = pk2(s[4 * 33], s[5 * 33]); o.w = pk2(s[6 * 33], s[7 * 33]);
        *(v4u*)(WT + (size_t)(n0 + n) * ldk + kofs + k0 + 8 * c) = o; }
    LDS_WAIT(); asm volatile("" ::: "memory");
}
__device__ __forceinline__ void fold_item(const float* wpool, const float* pscale, const float* wout, bf16* WoT, int g, int n0, LAS float* scr, int lane) {
#pragma unroll
    for (int i = 0; i < 4; ++i) { const int e = lane + 64 * i;
        const int d = e >> 1, h = e & 1; f32x4 v = *(const f32x4*)(wout + (size_t)(g * 128 + d) * D + n0 + 4 * h); v = v * pscale[g * 128 + d]; *(LAS f32x4*)(scr + d * 8 + 4 * h) = v; }
    LDS_WAIT(); asm volatile("" ::: "memory");
#pragma unroll 1
    for (int cc = 0; cc < 2; ++cc) { const int c = lane + 64 * cc; const float* wp = wpool + ((size_t)g * 128 + c) * 128;
        float acc[8];
#pragma unroll
        for (int n = 0; n < 8; ++n) acc[n] = 0.f;
#pragma unroll 2
        for (int d4 = 0; d4 < 32; ++d4) { const f32x4 w = *(const f32x4*)(wp + 4 * d4);
#pragma unroll
            for (int dd = 0; dd < 4; ++dd) { const f32x4 a = *(const LAS f32x4*)(scr + (4 * d4 + dd) * 8), b = *(const LAS f32x4*)(scr + (4 * d4 + dd) * 8 + 4);
                acc[0] += w[dd] * a[0]; acc[1] += w[dd] * a[1]; acc[2] += w[dd] * a[2]; acc[3] += w[dd] * a[3]; acc[4] += w[dd] * b[0]; acc[5] += w[dd] * b[1]; acc[6] += w[dd] * b[2]; acc[7] += w[dd] * b[3]; } }
#pragma unroll
        for (int n = 0; n < 8; ++n) WoT[(size_t)(n0 + n) * D + g * 128 + c] = (bf16)f2bf(acc[n]); }
    LDS_WAIT(); asm volatile("" ::: "memory");
}
struct In { const float *x, *c, *ctx, *c_ctx, *w_mod, *b_mod, *norm_ffn1, *w_ffn1_in, *w_ffn1_out, *norm_mix, *w_in, *w_pool, *pool_scale, *sink, *w_out, *norm_ffn2, *w_ffn2_in, *w_ffn2_out, *norm_final; };

__device__ __forceinline__ void prologue(const Frame& F, const In& I, unsigned char* ws) {
    float* mods = (float*)(ws + WS_MODS);
    {
        LAS float* sl = (LAS float*)F.lds;
        LAS float* red = (LAS float*)(F.lds + 20480);
        bool have = false;
        for (int it = F.bid; it < 72; it += F.G) {
            if (!have) { for (int e = F.tid; e < 5 * D; e += 512) { const float v = (e < 4 * D) ? I.c[e] : I.c_ctx[e - 4 * D]; sl[e] = v / (1.0f + __expf(-v)); } have = true; __syncthreads(); }
            const int l = it / 36, cgp = it % 36; const float* W = I.w_mod + (size_t)l * D * NMODV + cgp * 256 + 4 * F.lane;
            f32x4 acc[5];
#pragma unroll
            for (int b = 0; b < 5; ++b) acc[b] = (f32x4){0.f, 0.f, 0.f, 0.f};
            const int kb = F.wave * 128;
#pragma unroll 8
            for (int k = 0; k < 128; ++k) { const f32x4 w = __builtin_nontemporal_load((const f32x4*)(W + (size_t)(kb + k) * NMODV));
#pragma unroll
                for (int b = 0; b < 5; ++b) acc[b] += w * sl[b * D + kb + k]; }
#pragma unroll
            for (int b = 0; b < 5; ++b) *(LAS f32x4*)(red + (F.wave * 5 + b) * 256 + 4 * F.lane) = acc[b];
            __syncthreads();
            for (int e = F.tid; e < 5 * 256; e += 512) { const int b = e >> 8, cc = e & 255; float s = I.b_mod[(size_t)l * NMODV + cgp * 256 + cc];
#pragma unroll
                for (int w = 0; w < 8; ++w) s += red[(w * 5 + b) * 256 + cc];
                mods[((size_t)l * 5 + b) * NMODV + cgp * 256 + cc] = s; }
            __syncthreads();
        }
        __syncthreads();
    }
    LAS float* scr = (LAS float*)(F.lds + F.wave * 16384);
    const int gw = F.bid * NWAVES + F.wave, NGW = F.G * NWAVES;
    constexpr int I_FIN = (D / 64) * (NFF / 32), I_FOUT = (FF / 64) * (D / 32), I_IN = (D / 64) * (PW / 32), I_OUT = (512 / 64) * (D / 32), I_FOLD = 4 * (D / 8);
    constexpr int PER_L = 2 * I_FIN + 2 * I_FOUT + I_IN + I_OUT + I_FOLD, NITEMS = 2 * PER_L + 1;
    for (int it = gw; it < NITEMS; it += NGW) {
        if (it == 2 * PER_L) {
            float* rc = (float*)(ws + WS_ROPE); float* rs = rc + 1024;
            for (int f = 0; f < 16; ++f) { const float inv = powf(10000.0f, -(float)(2 * f) / 32.0f); const float a = (float)F.lane * inv; float s, c; sincosf(a, &s, &c); rc[F.lane * 16 + f] = c; rs[F.lane * 16 + f] = s; }
            continue;
        }
        const int l = it / PER_L; int r = it % PER_L; unsigned char* wl = ws + WS_W + (size_t)l * LW_BYTES;
        if (r < 2 * I_FIN) { const bool second = r >= I_FIN; if (second) r -= I_FIN; const float* W = (second ? I.w_ffn2_in : I.w_ffn1_in) + (size_t)l * D * NFF;
            const int nblk = NFF / 32, kb = r / nblk, nb = r % nblk; transpose_item(W, NFF, (bf16*)(wl + (second ? W_F2IN : W_F1IN)), D, 0, src_swiglu(32 * nb), 32 * nb, 64 * kb, scr, F.lane); continue; }
        r -= 2 * I_FIN;
        if (r < 2 * I_FOUT) { const bool second = r >= I_FOUT; if (second) r -= I_FOUT; const float* W = (second ? I.w_ffn2_out : I.w_ffn1_out) + (size_t)l * FF * D;
            const int nblk = D / 32, kb = r / nblk, nb = r % nblk; transpose_item(W, D, (bf16*)(wl + (second ? W_F2OUT : W_F1OUT)), FF, 0, 32 * nb, 32 * nb, 64 * kb, scr, F.lane); continue; }
        r -= 2 * I_FOUT;
        if (r < I_IN) { const float* W = I.w_in + (size_t)l * D * PW; const int nblk = PW / 32, kb = r / nblk, nb = r % nblk;
            transpose_item(W, PW, (bf16*)(wl + W_IN), D, 0, src_qkv(32 * nb), 32 * nb, 64 * kb, scr, F.lane); continue; }
        r -= I_IN;
        if (r < I_OUT) { const float* W = I.w_out + (size_t)l * D * D + (size_t)512 * D; const int nblk = D / 32, kb = r / nblk, nb = r % nblk;
            transpose_item(W, D, (bf16*)(wl + W_OUT), D, 512, 32 * nb, 32 * nb, 64 * kb, scr, F.lane); continue; }
        r -= I_OUT;
        { const int g = r / (D / 8), nb = r % (D / 8);
          fold_item(I.w_pool + (size_t)l * 4 * 128 * 128, I.pool_scale + (size_t)l * 512, I.w_out + (size_t)l * D * D, (bf16*)(wl + W_OUT), g, 8 * nb, scr, F.lane); }
    }
    { bf16* Hc = (bf16*)(ws + WS_H) + (size_t)ML * D; const int n4 = MC * D / 4;
      for (int e = F.bid * 512 + F.tid; e < n4; e += F.G * 512) { const f32x4 v = __builtin_nontemporal_load((const f32x4*)I.ctx + e); v2u w; w.x = pk2(v.x, v.y); w.y = pk2(v.z, v.w); ((v2u*)Hc)[e] = w; } }
}

template <bool NT = false> __device__ __forceinline__ void ld_row(const float* latf, const bf16* Hb, int m, int lane, f32x4 (&v)[4]) {
    if (latf != nullptr && m < ML) {
#pragma unroll
        for (int j = 0; j < 4; ++j) v[j] = __builtin_nontemporal_load((const f32x4*)(latf + (size_t)m * D + 4 * lane + 256 * j));
    } else {
#pragma unroll
        for (int j = 0; j < 4; ++j) { const v2u* p = (const v2u*)(Hb + (size_t)m * D + 4 * lane + 256 * j); const v2u w = NT ? __builtin_nontemporal_load(p) : *p; v[j] = (f32x4){bf_lo(w.x), bf_hi(w.x), bf_lo(w.y), bf_hi(w.y)}; } }
}
__device__ __forceinline__ void norm_phase(const Frame& F, const float* latf, bf16* Hb, bf16* XN, const float* g, const float* shift, const float* scale, int nrows, const bf16* slab, int nsplit) {
    const int gw = F.bid * NWAVES + F.wave, NGW = F.G * NWAVES; const int rpw = (ML + NGW - 1) / NGW;
    int m0 = gw * rpw, m1 = m0 + rpw; if (m1 > ML) m1 = ML; if (m0 > ML) m0 = ML;
    const int nctx = nrows - ML;
    int cur_b = -1; f32x4 gs[4], sh[4];
    for (int it = m0; it < m1 + 1; ++it) {
        int m = it;
        if (it == m1) { bool any = false; for (int r = gw; r < nctx; r += NGW) any = true; if (!any) break; m = ML + gw; }
        for (;; ) {
            const int b = m < ML ? (m >> 12) : 4;
            if (b != cur_b) { cur_b = b;
#pragma unroll
                for (int j = 0; j < 4; ++j) { const int col = 4 * F.lane + 256 * j; const f32x4 gv = *(const f32x4*)(g + col), sc = *(const f32x4*)(scale + (size_t)b * NMODV + col); gs[j] = gv * (sc + 1.0f); sh[j] = *(const f32x4*)(shift + (size_t)b * NMODV + col); } }
            f32x4 v[4]; float s = 0.f;
            ld_row(latf, Hb, m, F.lane, v);
            if (m >= ML && nsplit > 0) {
                const bf16* sp = slab + (size_t)(m - ML) * D + 4 * F.lane;
#pragma unroll 4
                for (int q = 0; q < nsplit; ++q) {
#pragma unroll
                    for (int j = 0; j < 4; ++j) { const v2u w = __builtin_nontemporal_load((const v2u*)(sp + (size_t)q * (MC * D) + 256 * j)); v[j] += (f32x4){bf_lo(w.x), bf_hi(w.x), bf_lo(w.y), bf_hi(w.y)}; } }
#pragma unroll
                for (int j = 0; j < 4; ++j) { v2u w; w.x = pk2(v[j].x, v[j].y); w.y = pk2(v[j].z, v[j].w); *(v2u*)(Hb + (size_t)m * D + 4 * F.lane + 256 * j) = w; }
            }
#pragma unroll
            for (int j = 0; j < 4; ++j) s += (v[j].x * v[j].x + v[j].y * v[j].y) + (v[j].z * v[j].z + v[j].w * v[j].w);
            const float rstd = 1.0f / sqrtf(wave_sum(s) * (1.0f / D) + 1e-6f);
            bf16* orow = XN + (size_t)m * D;
#pragma unroll
            for (int j = 0; j < 4; ++j) { const f32x4 o = v[j] * rstd * gs[j] + sh[j]; v2u w; w.x = pk2(o.x, o.y); w.y = pk2(o.z, o.w); *(v2u*)(orow + 4 * F.lane + 256 * j) = w; }
            if (m < ML) break;
            m += NGW; if (m >= ML + nctx) break;
        }
    }
}
__device__ __forceinline__ void final_norm(const Frame& F, const bf16* Hb, float* out, const float* g) {
    const int gw = F.bid * NWAVES + F.wave, NGW = F.G * NWAVES;
    f32x4 gv[4];
#pragma unroll
    for (int j = 0; j < 4; ++j) gv[j] = *(const f32x4*)(g + 4 * F.lane + 256 * j);
    for (int m = gw; m < ML; m += NGW) { f32x4 v[4]; float s = 0.f; ld_row<true>(nullptr, Hb, m, F.lane, v);
#pragma unroll
        for (int j = 0; j < 4; ++j) s += (v[j].x * v[j].x + v[j].y * v[j].y) + (v[j].z * v[j].z + v[j].w * v[j].w);
        const float rstd = 1.0f / sqrtf(wave_sum(s) * (1.0f / D) + 1e-6f);
#pragma unroll
        for (int j = 0; j < 4; ++j) __builtin_nontemporal_store(v[j] * rstd * gv[j], (f32x4*)(out + (size_t)m * D + 4 * F.lane + 256 * j)); }
}

constexpr int KROWB = 144;
constexpr int KBUF = 64 * KROWB;
__device__ __forceinline__ int crow(int r, int hi) { return (r & 3) + 8 * (r >> 2) + 4 * hi; }
__device__ __forceinline__ void attn_unit(const Frame& F, const bf16* QKV, bf16* MIX, const float* sink, int b, int kvh, int qt, bool isctx) {
    const int lane = F.lane, wid = F.wave, r32 = lane & 31, hi = lane >> 5, tid = F.tid;
    const int head = kvh * 4 + (wid >> 1), qh = wid & 1;
    const int qrow0 = isctx ? (ML + b * CTXL + qt * 64) : (b * SEQ + qt * 64);
    int lo = 0, nloc = 0;
    if (!isctx) { lo = qt - 2 < 0 ? 0 : qt - 2; const int hi_t = qt + 2 > 63 ? 63 : qt + 2; nloc = hi_t - lo + 1; }
    const int ntile = nloc + 4;
    bf16x8 qr[4];
    { const bf16* qp = QKV + (size_t)(qrow0 + 32 * qh + r32) * PW + 512 + head * 64 + hi * 8;
#pragma unroll
      for (int d0 = 0; d0 < 4; ++d0) qr[d0] = *(const bf16x8*)(qp + d0 * 16); }
    const int krow = tid >> 3, kch = tid & 7;
#define TILE_ROW(j) (((j) < nloc) ? (b * SEQ + (lo + (j)) * 64) : (ML + b * CTXL + ((j) - nloc) * 64))
#define LDK(j) (*(const v4u*)(QKV + (size_t)(TILE_ROW(j) + krow) * PW + 1024 + kvh * 64 + kch * 8))
#define LDV(j) (*(const v4u*)(QKV + (size_t)(TILE_ROW(j) + lane) * PW + 1152 + kvh * 64 + wid * 8))
    v4u kA = LDK(0), vA = LDV(0), kB = LDK(1), vB = LDV(1);
    float m_run = sink[head] * 1.4426950408889634f, l_run = (hi == 0) ? 1.0f : 0.0f;
    f32x16 o0 = {}, o1 = {};
    const int qpos = qt * 64 + 32 * qh + r32;
    auto stage = [&](int slot, const v4u& kreg, const v4u& vreg) __attribute__((always_inline)) {
        LAS unsigned char* kb = F.lds + slot * (2 * KBUF); LAS unsigned char* vb = kb + KBUF;
        *(LAS v4u*)(kb + krow * KROWB + kch * 16) = kreg;
        { LAS unsigned short* vt = (LAS unsigned short*)(vb + (wid * 8) * KROWB + lane * 2);
          vt[0 * (KROWB / 2)] = (unsigned short)(vreg.x & 0xffff); vt[1 * (KROWB / 2)] = (unsigned short)(vreg.x >> 16); vt[2 * (KROWB / 2)] = (unsigned short)(vreg.y & 0xffff); vt[3 * (KROWB / 2)] = (unsigned short)(vreg.y >> 16);
          vt[4 * (KROWB / 2)] = (unsigned short)(vreg.z & 0xffff); vt[5 * (KROWB / 2)] = (unsigned short)(vreg.z >> 16); vt[6 * (KROWB / 2)] = (unsigned short)(vreg.w & 0xffff); vt[7 * (KROWB / 2)] = (unsigned short)(vreg.w >> 16); }
    };
    auto compute = [&](int j, int slot) __attribute__((always_inline)) {
        LAS unsigned char* kb = F.lds + slot * (2 * KBUF); LAS unsigned char* vb = kb + KBUF;
        f32x16 p0 = {}, p1 = {};
#pragma unroll
        for (int d0 = 0; d0 < 4; ++d0) { const bf16x8 k0 = *(const LAS bf16x8*)(kb + r32 * KROWB + d0 * 32 + hi * 16), k1 = *(const LAS bf16x8*)(kb + (32 + r32) * KROWB + d0 * 32 + hi * 16);
            p0 = __builtin_amdgcn_mfma_f32_32x32x16_bf16(k0, qr[d0], p0, 0, 0, 0); p1 = __builtin_amdgcn_mfma_f32_32x32x16_bf16(k1, qr[d0], p1, 0, 0, 0); }
        if (j < nloc) { const int kbase = (lo + j) * 64 - qpos;
            const int dt = lo + j - qt;
            if (dt == -2 || dt == 2) {
#pragma unroll
                for (int r = 0; r < 16; ++r) { const int d0 = kbase + crow(r, hi), d1 = d0 + 32; if (d0 > 128 || d0 < -128) p0[r] = -1e30f; if (d1 > 128 || d1 < -128) p1[r] = -1e30f; } } }
        float mx = p0[0];
#pragma unroll
        for (int r = 1; r < 16; ++r) mx = fmaxf(mx, p0[r]);
#pragma unroll
        for (int r = 0; r < 16; ++r) mx = fmaxf(mx, p1[r]);
        mx = fmaxf(mx, __shfl_xor(mx, 32));
        const float mn = fmaxf(m_run, mx), alpha = __builtin_amdgcn_exp2f(m_run - mn); m_run = mn;
        float ps = 0.f;
#pragma unroll
        for (int r = 0; r < 16; ++r) { p0[r] = __builtin_amdgcn_exp2f(p0[r] - mn); p1[r] = __builtin_amdgcn_exp2f(p1[r] - mn); ps += p0[r] + p1[r]; }
        l_run = l_run * alpha + ps;
#pragma unroll
        for (int r = 0; r < 16; ++r) { o0[r] *= alpha; o1[r] *= alpha; }
#pragma unroll
        for (int c = 0; c < 4; ++c) {
            v4u pw;
            if (c == 0) { pw.x = pg8::cvt_pk_bf16(p0[0], p0[1]); pw.y = pg8::cvt_pk_bf16(p0[2], p0[3]); pw.z = pg8::cvt_pk_bf16(p0[4], p0[5]); pw.w = pg8::cvt_pk_bf16(p0[6], p0[7]); }
            else if (c == 1) { pw.x = pg8::cvt_pk_bf16(p0[8], p0[9]); pw.y = pg8::cvt_pk_bf16(p0[10], p0[11]); pw.z = pg8::cvt_pk_bf16(p0[12], p0[13]); pw.w = pg8::cvt_pk_bf16(p0[14], p0[15]); }
            else if (c == 2) { pw.x = pg8::cvt_pk_bf16(p1[0], p1[1]); pw.y = pg8::cvt_pk_bf16(p1[2], p1[3]); pw.z = pg8::cvt_pk_bf16(p1[4], p1[5]); pw.w = pg8::cvt_pk_bf16(p1[6], p1[7]); }
            else { pw.x = pg8::cvt_pk_bf16(p1[8], p1[9]); pw.y = pg8::cvt_pk_bf16(p1[10], p1[11]); pw.z = pg8::cvt_pk_bf16(p1[12], p1[13]); pw.w = pg8::cvt_pk_bf16(p1[14], p1[15]); }
            const bf16x8 pf = __builtin_bit_cast(bf16x8, pw);
#pragma unroll
            for (int dh = 0; dh < 2; ++dh) { const LAS unsigned char* vp = vb + (dh * 32 + r32) * KROWB + (16 * c + 4 * hi) * 2;
                const s16x4 a = *(const LAS s16x4*)vp, bq = *(const LAS s16x4*)(vp + 16);
                const bf16x8 vf = (bf16x8){a[0], a[1], a[2], a[3], bq[0], bq[1], bq[2], bq[3]};
                if (dh == 0) o0 = __builtin_amdgcn_mfma_f32_32x32x16_bf16(vf, pf, o0, 0, 0, 0); else o1 = __builtin_amdgcn_mfma_f32_32x32x16_bf16(vf, pf, o1, 0, 0, 0); }
        }
    };
    for (int j = 0, par = 0; j < ntile; j += 2, par ^= 2) {
        stage(par, kA, vA); if (j + 1 < ntile) stage(par + 1, kB, vB);
        asm volatile("s_waitcnt lgkmcnt(0)" ::: "memory"); __builtin_amdgcn_s_barrier(); asm volatile("" ::: "memory");
        if (j + 2 < ntile) { kA = LDK(j + 2); vA = LDV(j + 2); }
        if (j + 3 < ntile) { kB = LDK(j + 3); vB = LDV(j + 3); }
        compute(j, par); if (j + 1 < ntile) compute(j + 1, par + 1);
    }
#undef TILE_ROW
#undef LDK
#undef LDV
    const float lt = l_run + __shfl_xor(l_run, 32), inv = 1.0f / lt;
    bf16* op = MIX + (size_t)(qrow0 + 32 * qh + r32) * D + 512 + head * 64;
#pragma unroll
    for (int rq = 0; rq < 4; ++rq) { const int d = 8 * rq + 4 * hi;
        v2u w; w.x = pg8::cvt_pk_bf16(o0[4 * rq] * inv, o0[4 * rq + 1] * inv); w.y = pg8::cvt_pk_bf16(o0[4 * rq + 2] * inv, o0[4 * rq + 3] * inv); *(v2u*)(op + d) = w;
        w.x = pg8::cvt_pk_bf16(o1[4 * rq] * inv, o1[4 * rq + 1] * inv); w.y = pg8::cvt_pk_bf16(o1[4 * rq + 2] * inv, o1[4 * rq + 3] * inv); *(v2u*)(op + 32 + d) = w; }
    asm volatile("s_waitcnt lgkmcnt(0)" ::: "memory"); __builtin_amdgcn_s_barrier(); asm volatile("" ::: "memory");
}
template <int W> __device__ __forceinline__ void pool_seg(const bf16* QKV, bf16* MIX, int base, int Tn, int t0, int cc) {
    v4u rr[W + 7];
#pragma unroll
    for (int i = 0; i < W + 7; ++i) { const int tt = t0 - W / 2 + i; rr[i] = (v4u){0u, 0u, 0u, 0u}; if (tt >= 0 && tt < Tn) rr[i] = *(const v4u*)(QKV + (size_t)(base + tt) * PW + cc); }
#pragma unroll
    for (int r = 0; r < 8; ++r) { const int t = t0 + r; int lo = t - W / 2, hi = t + W - W / 2; if (lo < 0) lo = 0; if (hi > Tn) hi = Tn;
        float s[8];
#pragma unroll
        for (int i = 0; i < 8; ++i) s[i] = 0.f;
#pragma unroll
        for (int i = 0; i < W; ++i) { const v4u v = rr[r + i];
            s[0] += bf_lo(v.x); s[1] += bf_hi(v.x); s[2] += bf_lo(v.y); s[3] += bf_hi(v.y); s[4] += bf_lo(v.z); s[5] += bf_hi(v.z); s[6] += bf_lo(v.w); s[7] += bf_hi(v.w); }
        const float inv = 1.0f / (float)(hi - lo); const v4u u = rr[r + W / 2];
        v4u o; o.x = pk2(s[0] * inv - bf_lo(u.x), s[1] * inv - bf_hi(u.x)); o.y = pk2(s[2] * inv - bf_lo(u.y), s[3] * inv - bf_hi(u.y));
        o.z = pk2(s[4] * inv - bf_lo(u.z), s[5] * inv - bf_hi(u.z)); o.w = pk2(s[6] * inv - bf_lo(u.w), s[7] * inv - bf_hi(u.w));
        *(v4u*)(MIX + (size_t)(base + t) * D + cc) = o; }
}
__device__ __forceinline__ void pool_item(const Frame& F, const bf16* QKV, bf16* MIX, int r0) {
    int base, Tn; if (r0 < ML) { base = r0 & ~(SEQ - 1); Tn = SEQ; } else { base = ML + ((r0 - ML) & ~(CTXL - 1)); Tn = CTXL; }
    const int g = F.wave >> 1, cc = (g * 16 + (F.wave & 1) * 8 + (F.lane & 7)) * 8, t0 = (r0 - base) + (F.lane >> 3) * 8;
    if (g == 0) pool_seg<2>(QKV, MIX, base, Tn, t0, cc); else if (g == 1) pool_seg<4>(QKV, MIX, base, Tn, t0, cc); else if (g == 2) pool_seg<8>(QKV, MIX, base, Tn, t0, cc); else pool_seg<16>(QKV, MIX, base, Tn, t0, cc);
}
__device__ __forceinline__ void mixer_phase(const Frame& F, const bf16* QKV, bf16* MIX, const float* sink, bool do_ctx) {
    const int n_lat = NBATCH * 2 * 64, n_ctx = do_ctx ? NBATCH * 2 * 4 : 0, n_pool = (do_ctx ? MT : ML) / 64, total = n_lat + n_ctx + n_pool;
    for (int L = F.bid; L < total; L += F.G) {
        if (L < n_lat) { const int qt = L & 63, kvh = (L >> 6) & 1, b = L >> 7; attn_unit(F, QKV, MIX, sink, b, kvh, qt, false); }
        else if (L < n_lat + n_ctx) { const int u = L - n_lat; const int qt = u & 3, kvh = (u >> 2) & 1, b = u >> 3; attn_unit(F, QKV, MIX, sink, b, kvh, qt, true); }
        else pool_item(F, QKV, MIX, (L - n_lat - n_ctx) * 64);
    }
}

#define XB_TMO      128
#define XB_XCNT(j)  (256  + 64 * (j))
#define XB_XSUB(j)  (1280 + 64 * (j))
#define XB_XGEN(j)  (2304 + 64 * (j))
#define XB_TOP      3328
#define XB_TOPGEN   3392
#define XCD_BAR_WORDS 3456
#define XB_SPIN_CAP (1u << 18)

__device__ __forceinline__ unsigned xb_ld(unsigned* p)              { return __hip_atomic_load(p, __ATOMIC_RELAXED, __HIP_MEMORY_SCOPE_AGENT); }
__device__ __forceinline__ unsigned xb_add(unsigned* p, unsigned v) { return __hip_atomic_fetch_add(p, v, __ATOMIC_RELAXED, __HIP_MEMORY_SCOPE_AGENT); }
__device__ __forceinline__ unsigned xb_xcc_id() { return (unsigned)__builtin_amdgcn_s_getreg((3 << 11) | 20) & 0xFu; }
#define XB_SPIN(cond, bar) do { unsigned _sp = 0; while (cond) { __builtin_amdgcn_s_sleep(1); \
    if ((++_sp & 255u) == 0u) { if (xb_ld(&(bar)[XB_TMO])) break; if (_sp > XB_SPIN_CAP) { atomicAdd(&(bar)[XB_TMO], 1u); break; } } } } while (0)

struct XcdBarrier {
    unsigned* bar; unsigned x;
    volatile LAS unsigned* st;
};

__device__ __forceinline__ XcdBarrier xcd_barrier_post(unsigned* bar, volatile LAS unsigned* st) {
    XcdBarrier b; b.bar = bar; b.x = xb_xcc_id(); b.st = st;
    if (threadIdx.x == 0) (void)xb_add(&bar[XB_XCNT(b.x)], 1u);
    return b;
}
__device__ __forceinline__ void xcd_barrier_complete(unsigned* bar, unsigned x, unsigned& nloc, unsigned& nx) {
    const unsigned G = gridDim.x * gridDim.y * gridDim.z;
    unsigned sum, cnt, mine, sp = 0u;
    for (;;) {
        sum = 0u; cnt = 0u; mine = 0u;
#pragma unroll
        for (unsigned j = 0; j < 16; ++j) { const unsigned c = xb_ld(&bar[XB_XCNT(j)]); sum += c; cnt += (c > 0u) ? 1u : 0u; mine = (j == x) ? c : mine; }
        if (sum == G) break;
        __builtin_amdgcn_s_sleep(1);
        if ((++sp & 255u) == 0u) { if (xb_ld(&bar[XB_TMO])) break; if (sp > XB_SPIN_CAP) { atomicAdd(&bar[XB_TMO], 1u); break; } }
    }
    nloc = mine > 0u ? mine : 1u; nx = cnt > 0u ? cnt : 1u;
}

__device__ __forceinline__ void xcd_barrier(const XcdBarrier& b) {
    asm volatile("s_waitcnt vmcnt(0)" ::: "memory");
    __syncthreads();
    if (threadIdx.x == 0) {
        unsigned* bar = b.bar;
        __builtin_amdgcn_s_waitcnt(0);
        unsigned nloc = b.st[0], nx = b.st[1];
        if (nloc == 0u) { xcd_barrier_complete(bar, b.x, nloc, nx); b.st[0] = nloc; b.st[1] = nx; }
        const unsigned old = xb_add(&bar[XB_XSUB(b.x)], 1u);
        const unsigned gen = old / nloc;
        if (old + 1u == (gen + 1u) * nloc) {
            __builtin_amdgcn_fence(__ATOMIC_RELEASE, "agent");
            asm volatile("s_waitcnt vmcnt(0)" ::: "memory");
            const unsigned og = xb_add(&bar[XB_TOP], 1u);
            const unsigned tg = og / nx;
            if (og + 1u == (tg + 1u) * nx) xb_add(&bar[XB_TOPGEN], 1u);
            else XB_SPIN(xb_ld(&bar[XB_TOPGEN]) == tg, bar);
            __builtin_amdgcn_fence(__ATOMIC_ACQUIRE, "agent");
            xb_add(&bar[XB_XGEN(b.x)], 1u);
            asm volatile("s_waitcnt vmcnt(0)" ::: "memory");
        } else {
            XB_SPIN(xb_ld(&bar[XB_XGEN(b.x)]) == gen, bar);
            __builtin_amdgcn_fence(__ATOMIC_ACQUIRE, "agent");
            asm volatile("s_waitcnt vmcnt(0)" ::: "memory");
        }
    }
    __syncthreads();
}
#ifndef XP
#define XP 0
#endif
#define GSYNC() do { xcd_barrier(xbar); if (XP == 1) xcd_barrier(xbar); } while (0)
#define REPS(x) for (int rep_ = 0; rep_ < ((XP == (x)) ? 2 : 1); ++rep_)
#ifndef PHASES
#define PHASES 0xFFFF
#endif
#define PH(n) if (PHASES & (1 << (n)))
constexpr int LDS_BYTES = 147456;
struct Args { const void* p[21]; };
__device__ __forceinline__ const float* argf(const Args& a, int k) { asm volatile("" : "+s"(k)); return (const float*)a.p[k]; }
__device__ __forceinline__ unsigned char* argws(const Args& a) { int k = 20; asm volatile("" : "+s"(k)); return (unsigned char*)a.p[k]; }
#define MKFRAME() Frame F; F.lds = (LAS unsigned char*)lds; F.tid = threadIdx.x; asm volatile("" : "+v"(F.tid)); F.lane = F.tid & 63; F.wave = __builtin_amdgcn_readfirstlane(F.tid >> 6); F.G = gridDim.x; F.bid = blockIdx.x
__global__ void __launch_bounds__(NWAVES * 64, 2) fwd_megakernel(Args args) {
    extern __shared__ __attribute__((aligned(16))) unsigned char lds[];
    cg::grid_group grid = cg::this_grid();
    volatile LAS unsigned* xst = (volatile LAS unsigned*)((LAS unsigned char*)lds + 131072 + 64);
    if (threadIdx.x < 2) xst[threadIdx.x] = 0u;
    __syncthreads();
    const XcdBarrier xbar = xcd_barrier_post((unsigned*)(argws(args) + WS_BAR), xst);
    REPS(5) PH(0) { MKFRAME();
        In I; I.x = argf(args, 0); I.c = argf(args, 1); I.ctx = argf(args, 2); I.c_ctx = argf(args, 3); I.w_mod = argf(args, 4); I.b_mod = argf(args, 5); I.norm_ffn1 = argf(args, 6); I.w_ffn1_in = argf(args, 7); I.w_ffn1_out = argf(args, 8);
        I.norm_mix = argf(args, 9); I.w_in = argf(args, 10); I.w_pool = argf(args, 11); I.pool_scale = argf(args, 12); I.sink = argf(args, 13); I.w_out = argf(args, 14); I.norm_ffn2 = argf(args, 15); I.w_ffn2_in = argf(args, 16); I.w_ffn2_out = argf(args, 17); I.norm_final = argf(args, 18);
        prologue(F, I, argws(args)); }
    GSYNC();
    if (gridDim.x == 0x7fffffffu) grid.sync();
#pragma unroll 1
    for (int st = 0; st < 20; ++st) {
        const int l = st >= 10 ? 1 : 0, k = st - 10 * l;
        if (k == 0 || k == 3 || k == 7) { REPS(3) PH(1) { MKFRAME(); unsigned char* ws = argws(args); bf16* H = (bf16*)(ws + WS_H);
            const int j = (k == 0) ? 0 : (k == 3 ? 3 : 6); const float* ml = (const float*)(ws + WS_MODS) + (size_t)l * 5 * NMODV + j * D;
            const float* gw = argf(args, k == 0 ? 6 : (k == 3 ? 9 : 15)) + l * D;
            norm_phase(F, (st == 0) ? argf(args, 0) : nullptr, H, (bf16*)(ws + WS_XN), gw, ml, ml + D, (st == 17) ? ML : MT, (const bf16*)argf(args, 19), (st == 0 || st == 17) ? 0 : (k == 7 ? 4 : 11)); } }
        else if (k == 1 || k == 8) { REPS(6) PH(2) { unsigned char* ws = argws(args); unsigned char* wl = ws + WS_W + (size_t)l * LW_BYTES; const int nm = ((st == 18) ? ML : MT) / 256;
            pg8::Gemm g{(const bf16*)(ws + WS_XN), (const bf16*)(wl + (k == 1 ? W_F1IN : W_F2IN)), MT, NFF, D}; pg8::Sched<NFF / 256> S{nm, D / 64, (int)gridDim.x, (int)blockIdx.x, nm * (NFF / 256), 0, 1, 2};
            pg8::EpiSwiglu E{(bf16*)(ws + WS_ACT), FF}; pg8::gemm_phase<pg8::EpiSwiglu, pg8::Sched<NFF / 256>, true, true>((LAS unsigned char*)lds, g, S, E); } }
        else if (k == 2 || k == 6 || k == 9) { REPS(7) PH(3) { unsigned char* ws = argws(args); unsigned char* wl = ws + WS_W + (size_t)l * LW_BYTES; pg8::bf16_t* H = (pg8::bf16_t*)(ws + WS_H);
            const int j = (k == 2) ? 2 : (k == 6 ? 5 : 8); const float* gate = (const float*)(ws + WS_MODS) + (size_t)l * 5 * NMODV + j * D;
            const bool wo = (k == 6); const int nctx = (l == 1 && k != 2) ? 0 : 16; const bool nosplit = (XP == 2);
            pg8::Gemm g{(const bf16*)(ws + (wo ? WS_XN : WS_ACT)), (const bf16*)(wl + (k == 2 ? W_F1OUT : (wo ? W_OUT : W_F2OUT))), MT, D, wo ? D : FF};
            pg8::Sched<D / 256> S{ML / 256, (wo ? D : FF) / 64, (int)gridDim.x, (int)blockIdx.x, (ML / 256) * (D / 256), nosplit ? 0 : nctx, wo ? 4 : 11, 4}; if (nosplit) { S.nM = ML / 256 + nctx / 4; S.nmain = S.nM * 4; }
            pg8::EpiRes E{(st == 2 && rep_ == 0) ? argf(args, 0) : nullptr, H, gate, NMODV, (rep_ == 1) ? 0.0f : (wo ? 1.0f : 0.5f), (pg8::bf16_t*)argf(args, 19)}; pg8::gemm_phase<pg8::EpiRes, pg8::Sched<D / 256>, true, true>((LAS unsigned char*)lds, g, S, E); } }
        else if (k == 4) { REPS(8) PH(5) { unsigned char* ws = argws(args); unsigned char* wl = ws + WS_W + (size_t)l * LW_BYTES; const float* ropeC = (const float*)(ws + WS_ROPE);
            pg8::Gemm g{(const bf16*)(ws + WS_XN), (const bf16*)(wl + W_IN), MT, PW, D}; pg8::Sched<PW / 256> S{MT / 256, D / 64, (int)gridDim.x, (int)blockIdx.x, (MT / 256) * (PW / 256), 0, 1, 2};
            pg8::EpiQKV E{(bf16*)(ws + WS_ACT), ropeC, ropeC + 1024, C2}; pg8::gemm_phase<pg8::EpiQKV, pg8::Sched<PW / 256>, true, true>((LAS unsigned char*)lds, g, S, E); } }
        else { REPS(4) PH(6) { MKFRAME(); unsigned char* ws = argws(args); mixer_phase(F, (const bf16*)(ws + WS_ACT), (bf16*)(ws + WS_XN), argf(args, 13) + l * 8, l == 0); } }
        GSYNC();
    }
    PH(11) { MKFRAME(); unsigned char* ws = argws(args); int k = 19; asm volatile("" : "+s"(k)); final_norm(F, (const bf16*)(ws + WS_H), (float*)args.p[k], argf(args, 18)); }
}

extern "C" void kernel_launch(void* const* d_in, const int* in_sizes, int n_in, void* d_out, int out_size, void* d_ws, size_t ws_size, hipStream_t stream) {
    static int grid_blocks = 0;
    if (grid_blocks == 0) {
        if (n_in != 19 || out_size != ML * D || ws_size < WS_END) { fprintf(stderr, "kernel_launch: unexpected shapes (n_in %d, out %d, ws %zu < %zu)\n", n_in, out_size, ws_size, (size_t)WS_END); grid_blocks = -1; return; }
        int dev = 0, cus = 0, per_cu = 0;
        (void)hipGetDevice(&dev); (void)hipDeviceGetAttribute(&cus, hipDeviceAttributeMultiprocessorCount, dev);
        if (hipFuncSetAttribute((const void*)fwd_megakernel, hipFuncAttributeMaxDynamicSharedMemorySize, LDS_BYTES) != hipSuccess) { fprintf(stderr, "kernel_launch: hipFuncSetAttribute failed\n"); grid_blocks = -1; return; }
        if (hipOccupancyMaxActiveBlocksPerMultiprocessor(&per_cu, (const void*)fwd_megakernel, NWAVES * 64, LDS_BYTES) != hipSuccess || per_cu < 1) { fprintf(stderr, "kernel_launch: occupancy query gave %d\n", per_cu); per_cu = 1; }
        (void)hipGetLastError();
        grid_blocks = cus * per_cu;
    }
    if (grid_blocks < 0) return;
    if (hipMemsetAsync((char*)d_ws + WS_BAR, 0, XCD_BAR_WORDS * 4, stream) != hipSuccess) { fprintf(stderr, "kernel_launch: memset failed\n"); return; }
    Args a{};
    for (int i = 0; i < 19; ++i) a.p[i] = d_in[i];
    a.p[19] = d_out; a.p[20] = d_ws;
    void* kargs[] = {&a};
    hipError_t e = hipLaunchCooperativeKernel((const void*)fwd_megakernel, dim3(grid_blocks), dim3(NWAVES * 64), kargs, LDS_BYTES, stream);
    if (e != hipSuccess) fprintf(stderr, "kernel_launch: cooperative launch failed: %s (grid %d)\n", hipGetErrorString(e), grid_blocks);
}
```
